# Optimizing an MI355X kernel written in HIP

```python
import math
import jax, jax.numpy as jnp
from jax import lax
import numpy as np

D_MODEL = 2048
BATCH = 2
SEQ = 4096
DEPTH = 4

CHUNK = 64
N_BRANCH = 3
BRANCH_W = 3 * D_MODEL // 8
D_IN = 9 * BRANCH_W
POOL_WINDOWS = (2, 4, 8, 16)
POOL_GROUPS = len(POOL_WINDOWS)
POOL_GW = BRANCH_W // POOL_GROUPS
DA_QK_DIM = 64
DA_V_DIM = 2 * DA_QK_DIM
DA_HEADS = BRANCH_W // DA_V_DIM
Q_BLOCK = 128
NUM_BUCKETS = 32
MAX_DISTANCE = 128
SGU_CHUNK = 128
SGU_GW = 128
SGU_GROUPS = BRANCH_W // SGU_GW
EPS = 1e-6
NEG_INF = -1e30

kernel_name = "hybrid_pool_diffattn_sgu_trunk"


def rmsnorm(x, g):
    xf = x.astype(jnp.float32)
    y = xf * lax.rsqrt(jnp.mean(xf * xf, axis=-1, keepdims=True) + EPS)
    return (y * g.astype(jnp.float32)).astype(x.dtype)


def layernorm(x, g, b):
    xf = x.astype(jnp.float32)
    mu = jnp.mean(xf, axis=-1, keepdims=True)
    var = jnp.mean(jnp.square(xf - mu), axis=-1, keepdims=True)
    y = (xf - mu) * lax.rsqrt(var + EPS)
    return (y * g.astype(jnp.float32) + b.astype(jnp.float32)).astype(x.dtype)


def pool_mixer(xa, w, scale):
    B, S, _ = xa.shape
    xg = xa.reshape(B, S, POOL_GROUPS, POOL_GW).astype(jnp.float32)
    c = jnp.cumsum(xg, axis=1)
    c = jnp.concatenate([jnp.zeros_like(c[:, :1]), c], axis=1)
    t = jnp.arange(S)
    outs = []
    for g, wl in enumerate(POOL_WINDOWS):
        cg = c[:, :, g]
        upper = cg[:, 1:]
        lower = jnp.concatenate([jnp.zeros_like(cg[:, :wl - 1]), cg[:, :S + 1 - wl]], axis=1)
        count = jnp.minimum(t + 1, wl).astype(jnp.float32)[None, :, None]
        outs.append((upper - lower) / count - xg[:, :, g])
    pooled = jnp.stack(outs, axis=2).astype(xa.dtype)
    mixed = jnp.einsum('bsgc,gcd->bsgd', pooled, w)
    return mixed.reshape(B, S, BRANCH_W) * scale


def t5_bucket(rel):
    half = NUM_BUCKETS // 2
    max_exact = half // 2
    n = jnp.abs(rel)
    nf = jnp.maximum(n, max_exact).astype(jnp.float32)
    large = max_exact + (jnp.log(nf / max_exact) / math.log(MAX_DISTANCE / max_exact)
                         * (half - max_exact)).astype(jnp.int32)
    large = jnp.minimum(large, half - 1)
    return jnp.where(rel > 0, half, 0) + jnp.where(n < max_exact, n, large)


def diff_attention(q, k, v, lam, subln_g, rel_bias, lambda_init):
    B, S, _ = q.shape
    q = q.reshape(B, S, DA_HEADS, 2, DA_QK_DIM)
    k = k.reshape(B, S, DA_HEADS, 2, DA_QK_DIM)
    v = v.reshape(B, S, DA_HEADS, DA_V_DIM)
    lamf = lam.astype(jnp.float32)
    lam_full = (jnp.exp(jnp.sum(lamf[0] * lamf[1])) - jnp.exp(jnp.sum(lamf[2] * lamf[3]))
                + lambda_init)
    n_blocks = S // Q_BLOCK
    qb = q.reshape(B, n_blocks, Q_BLOCK, DA_HEADS, 2, DA_QK_DIM).transpose(1, 0, 2, 3, 4, 5)
    k1, k2 = k[..., 0, :], k[..., 1, :]
    k_pos = jnp.arange(S)
    k_chunk = k_pos // CHUNK
    table = rel_bias.astype(jnp.float32)
    scale = DA_QK_DIM ** -0.5

    def block(args):
        qblk, bi = args
        q_pos = bi * Q_BLOCK + jnp.arange(Q_BLOCK)
        mask = k_chunk[None, :] <= (q_pos // CHUNK)[:, None]
        bias = table[t5_bucket(k_pos[None, :] - q_pos[:, None])]
        bias = bias.transpose(2, 0, 1)[None]
        s1 = jnp.einsum('bqhd,bkhd->bhqk', qblk[..., 0, :], k1).astype(jnp.float32) * scale + bias
        s2 = jnp.einsum('bqhd,bkhd->bhqk', qblk[..., 1, :], k2).astype(jnp.float32) * scale + bias
        p1 = jax.nn.softmax(jnp.where(mask, s1, NEG_INF), axis=-1)
        p2 = jax.nn.softmax(jnp.where(mask, s2, NEG_INF), axis=-1)
        attn = (p1 - lam_full * p2).astype(v.dtype)
        return jnp.einsum('bhqk,bkhd->bqhd', attn, v)

    o = lax.map(block, (qb, jnp.arange(n_blocks)))
    o = o.transpose(1, 0, 2, 3, 4).reshape(B, S, DA_HEADS, DA_V_DIM)
    o = rmsnorm(o, subln_g) * (1.0 - lambda_init)
    return o.reshape(B, S, BRANCH_W)


def spatial_gating(u, v, norm_g, norm_b, w_s, b_s):
    B, S, _ = u.shape
    v = layernorm(v, norm_g, norm_b)
    nc = S // SGU_CHUNK
    vc = v.reshape(B, nc, SGU_CHUNK, SGU_GROUPS, SGU_GW)
    w_m = w_s * jnp.tril(jnp.ones((SGU_CHUNK, SGU_CHUNK), w_s.dtype))
    mixed = jnp.einsum('gpq,bnqgc->bnpgc', w_m, vc) + b_s.T[None, None, :, :, None]
    return u * mixed.reshape(B, S, BRANCH_W)


def hybrid_layer(x, rel_bias, g_pre, w_in, w_gate, pool_w, pool_scale, lam, subln_g,
                 sgu_norm_g, sgu_norm_b, sgu_w, sgu_b, w_branch, w_out, g_post, lambda_init):
    B, S, D = x.shape
    h = rmsnorm(x, g_pre)
    proj = h @ w_in
    a_x, a_g, q, k, v, b_g, c_u, c_v, c_g = jnp.split(proj, 9, axis=-1)
    y_a = pool_mixer(a_x, pool_w, pool_scale) * jax.nn.silu(a_g)
    y_b = diff_attention(q, k, v, lam, subln_g, rel_bias, lambda_init) * jax.nn.silu(b_g)
    y_c = spatial_gating(jax.nn.gelu(c_u), jax.nn.gelu(c_v), sgu_norm_g, sgu_norm_b,
                         sgu_w, sgu_b) * jax.nn.silu(c_g)
    branches = jnp.stack([y_a, y_b, y_c], axis=2)
    up = jnp.einsum('bsnw,nwd->bsnd', branches, w_branch)
    gates = jax.nn.sigmoid(h @ w_gate).reshape(B, S, N_BRANCH, D)
    merged = jnp.sum(gates * up, axis=2)
    out = merged @ w_out
    return x + rmsnorm(out, g_post)


def setup_inputs(seed: int = 0) -> dict:
    key = jax.random.key(seed)
    ks = jax.random.split(key, 16)
    f32 = jnp.float32
    nrm = lambda k, shape, s: jax.random.normal(k, shape, f32) * s
    return {
        "x": nrm(ks[0], (BATCH, SEQ, D_MODEL), 1.0),
        "rel_bias": nrm(ks[1], (NUM_BUCKETS, DA_HEADS), 0.5),
        "g_pre": 1.0 + nrm(ks[2], (DEPTH, D_MODEL), 0.05),
        "w_in": nrm(ks[3], (DEPTH, D_MODEL, D_IN), D_MODEL ** -0.5),
        "w_gate": nrm(ks[4], (DEPTH, D_MODEL, N_BRANCH * D_MODEL), D_MODEL ** -0.5),
        "pool_w": nrm(ks[5], (DEPTH, POOL_GROUPS, POOL_GW, POOL_GW), POOL_GW ** -0.5),
        "pool_scale": 1.0 + nrm(ks[6], (DEPTH, BRANCH_W), 0.05),
        "lam": nrm(ks[7], (DEPTH, 4, DA_QK_DIM), 0.1),
        "subln_g": 1.0 + nrm(ks[8], (DEPTH, DA_V_DIM), 0.05),
        "sgu_norm_g": 1.0 + nrm(ks[9], (DEPTH, BRANCH_W), 0.05),
        "sgu_norm_b": nrm(ks[10], (DEPTH, BRANCH_W), 0.02),
        "sgu_w": nrm(ks[11], (DEPTH, SGU_GROUPS, SGU_CHUNK, SGU_CHUNK), SGU_CHUNK ** -0.5),
        "sgu_b": 1.0 + nrm(ks[12], (DEPTH, SGU_GROUPS, SGU_CHUNK), 0.02),
        "w_branch": nrm(ks[13], (DEPTH, N_BRANCH, BRANCH_W, D_MODEL), BRANCH_W ** -0.5),
        "w_out": nrm(ks[14], (DEPTH, D_MODEL, D_MODEL), D_MODEL ** -0.5),
        "g_post": 1.0 + nrm(ks[15], (DEPTH, D_MODEL), 0.05),
    }


def reference(x, rel_bias, g_pre, w_in, w_gate, pool_w, pool_scale, lam, subln_g,
              sgu_norm_g, sgu_norm_b, sgu_w, sgu_b, w_branch, w_out, g_post):
    for i in range(DEPTH):
        lambda_init = 0.8 - 0.6 * math.exp(-0.3 * i)
        x = hybrid_layer(x, rel_bias, g_pre[i], w_in[i], w_gate[i], pool_w[i], pool_scale[i],
                         lam[i], subln_g[i], sgu_norm_g[i], sgu_norm_b[i], sgu_w[i], sgu_b[i],
                         w_branch[i], w_out[i], g_post[i], lambda_init)
    return x
```

```cpp
#include <hip/hip_runtime.h>
#include <hip/hip_cooperative_groups.h>
#include <cstdio>
#include <cstdint>
namespace cg = cooperative_groups;
namespace pg8 {
#define PG8_LAS __attribute__((address_space(3)))
typedef unsigned short bf16_t;
typedef short bf16x8 __attribute__((ext_vector_type(8)));
typedef float f32x4 __attribute__((ext_vector_type(4)));
typedef unsigned u32x4 __attribute__((ext_vector_type(4)));
constexpr int BM = 256, BK = 64, HALF = 128, HTB = HALF * BK * 2  , STAGE_BYTES = 8 * HTB, NXCD = 8, WGM = 8;

__host__ __device__ __forceinline__ int lds_byte(int r, int c) { const int st = (r >> 4) * 2 + (c >> 5), rr = r & 15, cc = c & 31, ob = rr * 64 + cc * 2; return st * 1024 + (ob ^ (((ob >> 9) & 1) << 5)); }
__host__ __device__ __forceinline__ void stage_rc(int b, int& R, int& C) { const int st = b / 1024, sb = b % 1024, swz = sb ^ (((sb >> 9) & 1) << 5); R = (st >> 1) * 16 + swz / 64; C = (st & 1) * 32 + (swz % 64) / 2; }
__host__ __device__ __forceinline__ int perm32(int rho) { const int n = rho >> 4, i = rho & 15; return 8 * (i >> 2) + 4 * n + (i & 3); }

struct Unit { int pm, pn; };
struct Gemm { const bf16_t* A; const bf16_t* Bt; int M, N, K; };

struct StaticOrder {
    int nM, nN, nwg, G, c;
    __host__ __device__ void init(int M, int N, int G_, int c_) { nM = M / BM; nN = N / BM; nwg = nM * nN; G = G_; c = c_; }
    __host__ __device__ bool next(int i, Unit& u) const {
        const long L = (long)i * G + c; if (L >= nwg) return false;
        int wgid = (int)L; { const int q = nwg / NXCD, r = nwg % NXCD, xcd = wgid % NXCD, off = wgid / NXCD; wgid = (xcd < r ? xcd * (q + 1) : r * (q + 1) + (xcd - r) * q) + off; }
        const int nig = WGM * nN, gid = wgid / nig, fm = gid * WGM, gsz = (nM - fm) < WGM ? (nM - fm) : WGM;
        u.pm = fm + ((wgid % nig) % gsz); u.pn = (wgid % nig) / gsz; return true;
    }
    __device__ __forceinline__ void a_ready(const Unit&) const {}
    __device__ __forceinline__ void done(const Unit&) const {}
};

__device__ __forceinline__ unsigned cvt_pk_bf16(float lo, float hi) { unsigned r; asm volatile("v_cvt_pk_bf16_f32 %0, %1, %2" : "=v"(r) : "v"(lo), "v"(hi)); return r; }
typedef float f32x2 __attribute__((ext_vector_type(2)));
__device__ __forceinline__ f32x2 gelu_pk(f32x2 v) {
    const f32x2 av = __builtin_elementwise_abs(v), d = av * 0.2316418882f + 1.0f;
    f32x2 t; t.x = __builtin_amdgcn_rcpf(d.x); t.y = __builtin_amdgcn_rcpf(d.y);
    f32x2 q = t * 0.5307027145f + (-0.7265760135f); q = q * t + 0.7107068705f; q = q * t + (-0.142248368f); q = q * t + 0.127414796f; q = q * t;
    const f32x2 s = (v * v) * (-0.72134752044f);
    f32x2 e; e.x = __builtin_amdgcn_exp2f(s.x); e.y = __builtin_amdgcn_exp2f(s.y);
    const f32x2 m = v * (q * e), r = v - m;
    f32x2 o; o.x = v.x < 0.f ? m.x : r.x; o.y = v.y < 0.f ? m.y : r.y; return o;
}


__device__ __forceinline__ float bf_lo(unsigned u) { return __uint_as_float(u << 16); }
__device__ __forceinline__ float bf_hi(unsigned u) { return __uint_as_float(u & 0xffff0000u); }
__device__ __forceinline__ float act_sig(float x, float na, float nb, bool mulx) {
    const float z = x * (na + nb * x * x);
    const float s = __builtin_amdgcn_rcpf(1.0f + __builtin_amdgcn_exp2f(z));
    return mulx ? x * s : s;
}
constexpr int TOK = 8192, BRW = 768, NGATE = 6144, DMODEL = 2048;
struct EpiG1 {
    static constexpr bool PERM = true, AFTER_DRAIN = false;
    bf16_t* proj; bf16_t* gates;
    __device__ __forceinline__ void operator()(const f32x4 (&acc)[2][2][4][2], const Unit& u, int wr, int wc, int fr, int fq) const {
        const int row0 = u.pm * BM + wr * 64 + fr; const int pn = u.pn;
        bf16_t* base; int ldc, colt, act;
        if (pn < 27) { const int s = pn / 3; base = proj + (size_t)s * TOK * BRW; ldc = BRW; colt = (pn - 3 * s) * BM; act = (s == 1 || s == 5 || s == 8) ? 1 : ((s == 6 || s == 7) ? 2 : 0); }
        else { base = gates; ldc = NGATE; colt = (pn - 27) * BM; act = 3; }
        const int col0 = colt + wc * 32 + 8 * fq;
        if (act == 0) {
#pragma unroll
            for (int ai = 0; ai < 2; ++ai)
#pragma unroll
                for (int m = 0; m < 4; ++m) { bf16_t* rowp = base + (size_t)(row0 + ai * HALF + m * 16) * ldc + col0;
#pragma unroll
                    for (int bj = 0; bj < 2; ++bj) { const f32x4 v0 = acc[ai][bj][m][0], v1 = acc[ai][bj][m][1];
                        u32x4 w; w.x = cvt_pk_bf16(v0[0], v0[1]); w.y = cvt_pk_bf16(v0[2], v0[3]); w.z = cvt_pk_bf16(v1[0], v1[1]); w.w = cvt_pk_bf16(v1[2], v1[3]);
                        *(u32x4*)(rowp + bj * HALF) = w; } }
        } else {
            const float L2E = 1.4426950408889634f;
            const float na = (act == 2) ? -L2E * 1.5957691216057308f : -L2E, nb = (act == 2) ? -L2E * 1.5957691216057308f * 0.044715f : 0.f; const bool mulx = (act != 3);
#pragma unroll
            for (int ai = 0; ai < 2; ++ai)
#pragma unroll
                for (int m = 0; m < 4; ++m) { bf16_t* rowp = base + (size_t)(row0 + ai * HALF + m * 16) * ldc + col0;
#pragma unroll
                    for (int bj = 0; bj < 2; ++bj) { const f32x4 v0 = acc[ai][bj][m][0], v1 = acc[ai][bj][m][1];
                        u32x4 w; w.x = cvt_pk_bf16(act_sig(v0[0], na, nb, mulx), act_sig(v0[1], na, nb, mulx)); w.y = cvt_pk_bf16(act_sig(v0[2], na, nb, mulx), act_sig(v0[3], na, nb, mulx));
                        w.z = cvt_pk_bf16(act_sig(v1[0], na, nb, mulx), act_sig(v1[1], na, nb, mulx)); w.w = cvt_pk_bf16(act_sig(v1[2], na, nb, mulx), act_sig(v1[3], na, nb, mulx));
                        *(u32x4*)(rowp + bj * HALF) = w; } }
        }
    }
};
struct EpiG2 {
    static constexpr bool PERM = true, AFTER_DRAIN = false;
    const bf16_t* gates; float* part; bf16_t* merged;
    __device__ __forceinline__ void operator()(const f32x4 (&acc)[2][2][4][2], const Unit& u, int wr, int wc, int fr, int fq) const {
        const int n = u.pm >> 5, pm = u.pm & 31, pn = u.pn & 7;
        const int row0 = pm * BM + wr * 64 + fr, col0 = pn * BM + wc * 32 + 8 * fq;
#pragma unroll
        for (int ai = 0; ai < 2; ++ai)
#pragma unroll
            for (int m = 0; m < 4; ++m) { const size_t r = (size_t)(row0 + ai * HALF + m * 16);
#pragma unroll
                for (int bj = 0; bj < 2; ++bj) { const int c = col0 + bj * HALF;
                    const u32x4 g = *(const u32x4*)(gates + r * NGATE + n * DMODEL + c);
                    f32x4 v0 = acc[ai][bj][m][0], v1 = acc[ai][bj][m][1];
                    v0[0] *= bf_lo(g.x); v0[1] *= bf_hi(g.x); v0[2] *= bf_lo(g.y); v0[3] *= bf_hi(g.y); v1[0] *= bf_lo(g.z); v1[1] *= bf_hi(g.z); v1[2] *= bf_lo(g.w); v1[3] *= bf_hi(g.w);
                    float* pp = part + r * DMODEL + c;
                    if (n == 0) { *(f32x4*)pp = v0; *(f32x4*)(pp + 4) = v1; }
                    else { v0 += *(const f32x4*)pp; v1 += *(const f32x4*)(pp + 4);
                        if (n == 1) { *(f32x4*)pp = v0; *(f32x4*)(pp + 4) = v1; }
                        else { u32x4 w; w.x = cvt_pk_bf16(v0[0], v0[1]); w.y = cvt_pk_bf16(v0[2], v0[3]); w.z = cvt_pk_bf16(v1[0], v1[1]); w.w = cvt_pk_bf16(v1[2], v1[3]); *(u32x4*)(merged + r * DMODEL + c) = w; } }
                } }
    }
};
struct G2Order {
    int G, c;
    __device__ bool next(int i, Unit& u) const { const int k = i / 3, n = i - 3 * k; const int pr = c + k * G; if (pr >= 256) return false; u.pm = n * 32 + (pr >> 3); u.pn = n * 8 + (pr & 7); return true; }
    __device__ __forceinline__ void a_ready(const Unit&) const {}
    __device__ __forceinline__ void done(const Unit&) const {}
};
struct EpiG3 {
    static constexpr bool PERM = true, AFTER_DRAIN = false;
    float* out;
    __device__ __forceinline__ void operator()(const f32x4 (&acc)[2][2][4][2], const Unit& u, int wr, int wc, int fr, int fq) const {
        const int row0 = u.pm * BM + wr * 64 + fr, col0 = u.pn * BM + wc * 32 + 8 * fq;
#pragma unroll
        for (int ai = 0; ai < 2; ++ai)
#pragma unroll
            for (int m = 0; m < 4; ++m) { float* rowp = out + (size_t)(row0 + ai * HALF + m * 16) * DMODEL + col0;
#pragma unroll
                for (int bj = 0; bj < 2; ++bj) { *(f32x4*)(rowp + bj * HALF) = acc[ai][bj][m][0]; *(f32x4*)(rowp + bj * HALF + 4) = acc[ai][bj][m][1]; } }
    }
};
template <class Epi, class Sched, bool ALIGN_EPI = false, bool SP2 = false>
__device__ __forceinline__ void gemm_phase(PG8_LAS unsigned char* lds, const Gemm g, const Sched& S, const Epi& E) {
    int tid_ = threadIdx.x; asm volatile("" : "+v"(tid_));
    const int tid = tid_, wid = __builtin_amdgcn_readfirstlane(tid >> 6), lane = tid & 63, wr = wid >> 2, wc = wid & 3, fr = lane & 15, fq = lane >> 4;
    const int K = g.K, nt = K / BK;
    unsigned voffA[2], voffB[2];
#pragma unroll
    for (int i = 0; i < 2; ++i) { int R, C; stage_rc(tid * 16 + i * 8192, R, C); const int Rb = Epi::PERM ? ((R & ~31) + perm32(R & 31)) : R;
        voffA[i] = (unsigned)(R * K + C) * 2u; voffB[i] = (unsigned)(Rb * K + C) * 2u; }
    const size_t kstep = (size_t)(BK * 2);
    const size_t hstep = (size_t)HALF * K * 2;
    const size_t tstep = 2 * hstep;
    const unsigned ldsw = (unsigned)wid * 1024u;
    const int aoff = lds_byte(wr * 64 + fr, fq * 8), boff = lds_byte(wc * 32 + fr, fq * 8);
#define PG8_SA(b, h) (((b) * 2 + (h)) * HTB)
#define PG8_SB(b, h) ((4 + (b) * 2 + (h)) * HTB)
#define PG8_STAGE(bufoff, gbase, voff) do { _Pragma("unroll") for (int _i = 0; _i < 2; ++_i) \
        __builtin_amdgcn_global_load_lds((const unsigned*)((const char*)(gbase) + (voff)[_i]), (PG8_LAS unsigned*)(lds + (bufoff) + ldsw + _i * 8192), 16, 0, 0); } while (0)
#define PG8_LDA(dst, b, h) do { _Pragma("unroll") for (int m = 0; m < 4; ++m) _Pragma("unroll") for (int k = 0; k < 2; ++k) dst[m][k] = *(const PG8_LAS bf16x8*)(lds + PG8_SA(b, h) + aoff + m * 2048 + k * 1024); } while (0)
#define PG8_LDB(dst, b, h) do { _Pragma("unroll") for (int n = 0; n < 2; ++n) _Pragma("unroll") for (int k = 0; k < 2; ++k) dst[n][k] = *(const PG8_LAS bf16x8*)(lds + PG8_SB(b, h) + boff + n * 2048 + k * 1024); } while (0)
#define PG8_MMA(ai, bj, At, Bt) do { __builtin_amdgcn_s_setprio(1); _Pragma("unroll") for (int m = 0; m < 4; ++m) _Pragma("unroll") for (int n = 0; n < 2; ++n) _Pragma("unroll") for (int k = 0; k < 2; ++k) \
        acc[ai][bj][m][n] = __builtin_amdgcn_mfma_f32_16x16x32_bf16(Bt[n][k], At[m][k], acc[ai][bj][m][n], 0, 0, 0); __builtin_amdgcn_s_setprio(0); } while (0)
#define PG8_WAIT_V(n) asm volatile("s_waitcnt vmcnt(" #n ")" ::: "memory")
#define PG8_WAIT_L(n) asm volatile("s_waitcnt lgkmcnt(" #n ")" ::: "memory")
#define PG8_BAR __builtin_amdgcn_s_barrier()
#define PG8_SCHED __builtin_amdgcn_sched_barrier(0)
    Unit cur, nxt; int ui = 0;
    if (!S.next(0, cur)) return;
    f32x4 acc[2][2][4][2];
#pragma unroll
    for (int a = 0; a < 2; ++a)
#pragma unroll
        for (int b = 0; b < 2; ++b)
#pragma unroll
            for (int m = 0; m < 4; ++m)
#pragma unroll
                for (int n = 0; n < 2; ++n) acc[a][b][m][n] = (f32x4){0.f, 0.f, 0.f, 0.f};
    bf16x8 At[4][2], B0[2][2], B1[2][2];
    const char* cA = (const char*)g.A + (size_t)cur.pm * tstep; const char* cB = (const char*)g.Bt + (size_t)cur.pn * tstep;
    S.a_ready(cur);
    if constexpr (SP2) {
        PG8_STAGE(PG8_SB(0, 0), cB, voffB); PG8_STAGE(PG8_SB(0, 1), cB + hstep, voffB); PG8_STAGE(PG8_SA(0, 0), cA, voffA); PG8_STAGE(PG8_SA(0, 1), cA + hstep, voffA);
        if (wr == 1) PG8_BAR;
        PG8_WAIT_V(2); PG8_BAR;
        PG8_STAGE(PG8_SB(1, 0), cB + kstep, voffB); PG8_STAGE(PG8_SA(1, 0), cA + kstep, voffA); PG8_STAGE(PG8_SB(1, 1), cB + hstep + kstep, voffB);
        PG8_WAIT_V(6); PG8_BAR;
    } else {
        PG8_STAGE(PG8_SB(0, 0), cB, voffB); PG8_STAGE(PG8_SA(0, 0), cA, voffA); PG8_STAGE(PG8_SB(0, 1), cB + hstep, voffB); PG8_STAGE(PG8_SA(0, 1), cA + hstep, voffA);
        if (wr == 1) PG8_BAR;
        PG8_WAIT_V(4); PG8_BAR;
        PG8_STAGE(PG8_SB(1, 0), cB + kstep, voffB); PG8_STAGE(PG8_SA(1, 0), cA + kstep, voffA); PG8_STAGE(PG8_SB(1, 1), cB + hstep + kstep, voffB);
        PG8_WAIT_V(6); PG8_BAR;
    }
    for (;;) {
        const bool has_next = S.next(ui + 1, nxt);
        const char* nA = has_next ? (const char*)g.A + (size_t)nxt.pm * tstep : cA; const char* nB = has_next ? (const char*)g.Bt + (size_t)nxt.pn * tstep : cB;
        for (int t = 0; t < nt; t += 2) {
            const bool last = (t == nt - 2);
            const char* a1 = cA + (size_t)(t + 1) * kstep;
            const char* a2 = last ? nA : cA + (size_t)(t + 2) * kstep; const char* b2 = last ? nB : cB + (size_t)(t + 2) * kstep;
            const char* a3 = a2 + kstep; const char* b3 = b2 + kstep;
            if (last && has_next) S.a_ready(nxt);
            if constexpr (SP2) {
            PG8_LDB(B0, 0, 0); PG8_LDB(B1, 0, 1); PG8_SCHED; PG8_LDA(At, 0, 0); PG8_STAGE(PG8_SA(1, 1), a1 + hstep, voffA);
            PG8_WAIT_V(8); PG8_WAIT_L(0); PG8_BAR; PG8_MMA(0, 0, At, B0); PG8_MMA(0, 1, At, B1); PG8_BAR; PG8_SCHED;
            PG8_LDA(At, 0, 1); PG8_STAGE(PG8_SB(0, 0), b2, voffB); PG8_STAGE(PG8_SB(0, 1), b2 + hstep, voffB); PG8_STAGE(PG8_SA(0, 0), a2, voffA);
            PG8_WAIT_V(8); PG8_WAIT_L(0); PG8_BAR; PG8_MMA(1, 0, At, B0); PG8_MMA(1, 1, At, B1); PG8_BAR; PG8_SCHED;
            PG8_LDB(B0, 1, 0); PG8_LDB(B1, 1, 1); PG8_SCHED; PG8_LDA(At, 1, 0); PG8_STAGE(PG8_SA(0, 1), a2 + hstep, voffA);
            PG8_WAIT_V(8); PG8_WAIT_L(0); PG8_BAR; PG8_MMA(0, 0, At, B0); PG8_MMA(0, 1, At, B1); PG8_BAR; PG8_SCHED;
            PG8_LDA(At, 1, 1); PG8_STAGE(PG8_SB(1, 0), b3, voffB); PG8_STAGE(PG8_SB(1, 1), b3 + hstep, voffB); PG8_STAGE(PG8_SA(1, 0), a3, voffA);
            PG8_WAIT_V(8); PG8_WAIT_L(0); PG8_BAR; PG8_MMA(1, 0, At, B0); PG8_MMA(1, 1, At, B1); PG8_BAR; PG8_SCHED;
            } else {
            PG8_LDB(B0, 0, 0); PG8_SCHED; PG8_LDA(At, 0, 0); PG8_STAGE(PG8_SA(1, 1), a1 + hstep, voffA);
            PG8_WAIT_L(8); PG8_BAR; PG8_WAIT_L(0); PG8_MMA(0, 0, At, B0); PG8_BAR; PG8_SCHED;
            PG8_LDB(B1, 0, 1); PG8_STAGE(PG8_SB(0, 0), b2, voffB);
            PG8_BAR; PG8_WAIT_L(0); PG8_MMA(0, 1, At, B1); PG8_BAR;
            PG8_LDA(At, 0, 1); PG8_STAGE(PG8_SA(0, 0), a2, voffA);
            PG8_BAR; PG8_WAIT_L(0); PG8_MMA(1, 0, At, B0); PG8_BAR; PG8_SCHED;
            PG8_STAGE(PG8_SB(0, 1), b2 + hstep, voffB);
            PG8_WAIT_V(6); PG8_BAR; PG8_MMA(1, 1, At, B1); PG8_BAR;
            PG8_LDB(B0, 1, 0); PG8_SCHED; PG8_LDA(At, 1, 0); PG8_STAGE(PG8_SA(0, 1), a2 + hstep, voffA);
            PG8_WAIT_L(8); PG8_BAR; PG8_WAIT_L(0); PG8_MMA(0, 0, At, B0); PG8_BAR; PG8_SCHED;
            PG8_LDB(B1, 1, 1); PG8_STAGE(PG8_SB(1, 0), b3, voffB);
            PG8_BAR; PG8_WAIT_L(0); PG8_MMA(0, 1, At, B1); PG8_BAR;
            PG8_LDA(At, 1, 1); PG8_STAGE(PG8_SA(1, 0), a3, voffA);
            PG8_BAR; PG8_WAIT_L(0); PG8_MMA(1, 0, At, B0); PG8_BAR; PG8_SCHED;
            PG8_STAGE(PG8_SB(1, 1), b3 + hstep, voffB);
            PG8_WAIT_V(6); PG8_BAR; PG8_MMA(1, 1, At, B1); PG8_BAR;
            }
        }
        if constexpr (ALIGN_EPI) { if (wr == 0) PG8_BAR; }
        if constexpr (!Epi::AFTER_DRAIN) { E(acc, cur, wr, wc, fr, fq); S.done(cur); }
        if (!has_next) break;
#pragma unroll
        for (int a = 0; a < 2; ++a)
#pragma unroll
            for (int b = 0; b < 2; ++b)
#pragma unroll
                for (int m = 0; m < 4; ++m)
#pragma unroll
                    for (int n = 0; n < 2; ++n) acc[a][b][m][n] = (f32x4){0.f, 0.f, 0.f, 0.f};
        cur = nxt; cA = nA; cB = nB; ++ui;
        if constexpr (ALIGN_EPI) { if (wr == 1) PG8_BAR; }
    }
    PG8_WAIT_V(0);
    if constexpr (!ALIGN_EPI) { if (wr == 0) PG8_BAR; }
    PG8_BAR;
    if constexpr (Epi::AFTER_DRAIN) { E.fused(acc, cur, wr, wc, fr, fq, lds, wid, lane); S.done(cur); }
#undef PG8_SA
#undef PG8_SB
#undef PG8_STAGE
#undef PG8_LDA
#undef PG8_LDB
#undef PG8_MMA
#undef PG8_WAIT_V
#undef PG8_WAIT_L
#undef PG8_BAR
#undef PG8_SCHED
}
}

#ifndef PG8_SP2
#define PG8_SP2 true
#endif
#ifndef PG8_ALIGN
#define PG8_ALIGN true
#endif

#define LAS __attribute__((address_space(3)))
typedef unsigned short bf16_t;
typedef short bf16x8 __attribute__((ext_vector_type(8)));
typedef short s16x4 __attribute__((ext_vector_type(4)));
typedef float f32x4 __attribute__((ext_vector_type(4)));
typedef float f32x2 __attribute__((ext_vector_type(2)));
typedef unsigned u32x4 __attribute__((ext_vector_type(4)));
typedef unsigned u32x2 __attribute__((ext_vector_type(2)));
using pg8::cvt_pk_bf16; using pg8::bf_lo; using pg8::bf_hi;

constexpr int NB = 2, SEQ = 4096, DM = 2048, DEPTH = 4, M = NB * SEQ, BW = 768, DIN = 6912, NGT = 6144, N1 = DIN + NGT;
constexpr int NH = 6;
constexpr float EPS = 1e-6f, L2E = 1.4426950408889634f;
constexpr int NWAVES = 8, NTHR = 512;
constexpr int LDS_BYTES = 147456;

constexpr size_t SZ_W1T = (size_t)N1 * DM * 2, SZ_WBT = (size_t)3 * DM * BW * 2, SZ_WOT = (size_t)DM * DM * 2, SZ_WPT = (size_t)4 * 192 * 192 * 2;
constexpr size_t WS_W1T = 1u << 20;
constexpr size_t WS_WBT = WS_W1T + DEPTH * SZ_W1T;
constexpr size_t WS_WOT = WS_WBT + DEPTH * SZ_WBT;
constexpr size_t WS_WPT = WS_WOT + DEPTH * SZ_WOT;
constexpr size_t WS_H = (WS_WPT + DEPTH * SZ_WPT + 4095) & ~(size_t)4095;
constexpr size_t WS_PROJ = WS_H + (size_t)M * DM * 2;
constexpr size_t WS_GATES = WS_PROJ + (size_t)9 * M * BW * 2;
constexpr size_t WS_Y = WS_GATES + (size_t)M * NGT * 2;
constexpr size_t WS_MERGED = WS_Y + (size_t)3 * M * BW * 2;
constexpr size_t WS_OUT = WS_MERGED + (size_t)M * DM * 2;
constexpr size_t WS_END = WS_OUT + (size_t)M * DM * 4;

struct Params {
    const float *x, *rel_bias, *g_pre, *w_in, *w_gate, *pool_w, *pool_scale, *lam, *subln_g, *sgu_ng, *sgu_nb, *sgu_w, *sgu_b, *w_branch, *w_out, *g_post;
    float* out; unsigned char* ws;
};

__device__ __forceinline__ float wave_sum(float v) {
#pragma unroll
    for (int o = 1; o < 64; o <<= 1) v += __shfl_xor(v, o);
    return v;
}
__device__ __forceinline__ float dot4(f32x4 a) { return (a.x * a.x + a.y * a.y) + (a.z * a.z + a.w * a.w); }

__device__ __forceinline__ void transpose_item(const float* W, int K, int N, bf16_t* WT, int row_off, LAS float* scr, int item, int lane) {
    const int nblk = N / 32, kb = item / nblk, nb = item % nblk, k0 = 64 * kb, n0 = 32 * nb;
#pragma unroll 8
    for (int i = 0; i < 32; ++i) { const int kk = 2 * i + (lane >> 5); scr[kk * 33 + (lane & 31)] = W[(size_t)(k0 + kk) * N + n0 + (lane & 31)]; }
    asm volatile("s_waitcnt lgkmcnt(0)" ::: "memory");
    const int c = lane & 7;
#pragma unroll
    for (int j = 0; j < 4; ++j) { const int n = (lane >> 3) + 8 * j; const LAS float* s = scr + (8 * c) * 33 + n;
        u32x4 o; o.x = cvt_pk_bf16(s[0 * 33], s[1 * 33]); o.y = cvt_pk_bf16(s[2 * 33], s[3 * 33]); o.z = cvt_pk_bf16(s[4 * 33], s[5 * 33]); o.w = cvt_pk_bf16(s[6 * 33], s[7 * 33]);
        *(u32x4*)(WT + (size_t)(row_off + n0 + n) * K + k0 + 8 * c) = o; }
    asm volatile("s_waitcnt lgkmcnt(0)" ::: "memory");
}

__device__ __forceinline__ void rms_row_to_bf16(const float* xrow, const float* g, bf16_t* orow, int lane) {
    const f32x4* xr = (const f32x4*)xrow + lane; const f32x4* gr = (const f32x4*)g + lane;
    f32x4 v[8]; float s = 0.f;
#pragma unroll
    for (int j = 0; j < 8; ++j) { v[j] = xr[64 * j]; s += dot4(v[j]); }
    const float rstd = 1.0f / sqrtf(wave_sum(s) * (1.f / DM) + EPS);
    u32x2* o8 = (u32x2*)orow + lane;
#pragma unroll
    for (int j = 0; j < 8; ++j) { const f32x4 gg = gr[64 * j]; u32x2 w; w.x = cvt_pk_bf16(v[j].x * rstd * gg.x, v[j].y * rstd * gg.y); w.y = cvt_pk_bf16(v[j].z * rstd * gg.z, v[j].w * rstd * gg.w); o8[64 * j] = w; }
}

constexpr int I_IN = 32 * 216, I_G = 32 * 192, I_B1 = 12 * 64, I_B = 3 * I_B1, I_O = 32 * 64, I_P1 = 18, I_P = 4 * I_P1, I_LAYER = I_IN + I_G + I_B + I_O + I_P;

__device__ __forceinline__ void prologue(const Params& p, LAS unsigned char* lds, int vcu, int G) {
    int tid = threadIdx.x; asm volatile("" : "+v"(tid)); const int lane = tid & 63, wave = __builtin_amdgcn_readfirstlane(tid >> 6); const int gw = vcu * NWAVES + wave, NGW = G * NWAVES;
    LAS float* scr = (LAS float*)(lds + wave * 16384);
    unsigned char* ws = p.ws;
    for (int it = gw; it < DEPTH * I_LAYER; it += NGW) {
        const int l = it / I_LAYER; int r = it - l * I_LAYER;
        bf16_t* w1t = (bf16_t*)(ws + WS_W1T + l * SZ_W1T);
        if (r < I_IN) { transpose_item(p.w_in + (size_t)l * DM * DIN, DM, DIN, w1t, 0, scr, r, lane); continue; } r -= I_IN;
        if (r < I_G) { transpose_item(p.w_gate + (size_t)l * DM * NGT, DM, NGT, w1t, DIN, scr, r, lane); continue; } r -= I_G;
        if (r < I_B) { const int n = r / I_B1, rr = r - n * I_B1; transpose_item(p.w_branch + (size_t)(l * 3 + n) * BW * DM, BW, DM, (bf16_t*)(ws + WS_WBT + l * SZ_WBT) + (size_t)n * DM * BW, 0, scr, rr, lane); continue; } r -= I_B;
        if (r < I_O) { transpose_item(p.w_out + (size_t)l * DM * DM, DM, DM, (bf16_t*)(ws + WS_WOT + l * SZ_WOT), 0, scr, r, lane); continue; } r -= I_O;
        { const int g = r / I_P1, rr = r - g * I_P1; transpose_item(p.pool_w + (size_t)(l * 4 + g) * 192 * 192, 192, 192, (bf16_t*)(ws + WS_WPT + l * SZ_WPT) + g * 192 * 192, 0, scr, rr, lane); }
    }
    for (int m = gw; m < M; m += NGW) rms_row_to_bf16(p.x + (size_t)m * DM, p.g_pre, (bf16_t*)(ws + WS_H) + (size_t)m * DM, lane);
}

__device__ __forceinline__ void rowpass(const float* xin, float* xout, const float* outb, const float* gpost, const float* gnext, bf16_t* H, int vcu, int G) {
    int tid = threadIdx.x; asm volatile("" : "+v"(tid)); const int lane = tid & 63, wave = __builtin_amdgcn_readfirstlane(tid >> 6); const int gw = vcu * NWAVES + wave, NGW = G * NWAVES;
    for (int m = gw; m < M; m += NGW) {
        const f32x4* o4 = (const f32x4*)(outb + (size_t)m * DM) + lane; const f32x4* x4 = (const f32x4*)(xin + (size_t)m * DM) + lane;
        f32x4* xo = (f32x4*)(xout + (size_t)m * DM) + lane; const f32x4* gp = (const f32x4*)gpost + lane;
        f32x4 o[8]; float ss = 0.f;
#pragma unroll
        for (int j = 0; j < 8; ++j) { o[j] = o4[64 * j]; ss += dot4(o[j]); }
        const float rstd = 1.0f / sqrtf(wave_sum(ss) * (1.f / DM) + EPS);
        float s2 = 0.f;
#pragma unroll
        for (int j = 0; j < 8; ++j) { const f32x4 g = gp[64 * j]; const f32x4 xv = x4[64 * j]; o[j] = xv + o[j] * rstd * g; s2 += dot4(o[j]); xo[64 * j] = o[j]; }
        if (gnext) {
            const float r2 = 1.0f / sqrtf(wave_sum(s2) * (1.f / DM) + EPS);
            const f32x4* gn = (const f32x4*)gnext + lane; u32x2* h8 = (u32x2*)(H + (size_t)m * DM) + lane;
#pragma unroll
            for (int j = 0; j < 8; ++j) { const f32x4 g = gn[64 * j]; u32x2 w; w.x = cvt_pk_bf16(o[j].x * r2 * g.x, o[j].y * r2 * g.y); w.y = cvt_pk_bf16(o[j].z * r2 * g.z, o[j].w * r2 * g.w); h8[64 * j] = w; }
        }
    }
}

__device__ __forceinline__ bf16x8 mk8(u32x4 v) { return __builtin_bit_cast(bf16x8, v); }
#define MFMA16(a, b, c) __builtin_amdgcn_mfma_f32_16x16x32_bf16((a), (b), (c), 0, 0, 0)

__device__ __forceinline__ void pool_unit(LAS unsigned char* lds, int u, const bf16_t* ax, const bf16_t* ag, const bf16_t* wpt, const float* pscale, bf16_t* y0) {
    int tid = threadIdx.x; asm volatile("" : "+v"(tid)); const int lane = tid & 63, wave = __builtin_amdgcn_readfirstlane(tid >> 6);
    const int tt = u >> 2, g = u & 3, wl = 2 << g, t0 = tt * 128;
    for (int it = tid; it < 128 * 24; it += NTHR) {
        const int r = it / 24, ch = it - r * 24; const int t = t0 + r, ts = t & (SEQ - 1);
        const int cnt = (ts + 1 < wl) ? ts + 1 : wl;
        const bf16_t* src = ax + (size_t)t * BW + g * 192 + ch * 8;
        const u32x4 cur = *(const u32x4*)src;
        f32x4 xa = {bf_lo(cur.x), bf_hi(cur.x), bf_lo(cur.y), bf_hi(cur.y)}, xb = {bf_lo(cur.z), bf_hi(cur.z), bf_lo(cur.w), bf_hi(cur.w)};
        f32x4 sa = xa, sb = xb;
        for (int k = 1; k < cnt; ++k) { const u32x4 v = *(const u32x4*)(src - (size_t)k * BW);
            sa += (f32x4){bf_lo(v.x), bf_hi(v.x), bf_lo(v.y), bf_hi(v.y)}; sb += (f32x4){bf_lo(v.z), bf_hi(v.z), bf_lo(v.w), bf_hi(v.w)}; }
        const float ic = 1.0f / (float)cnt;
        sa = sa * ic - xa; sb = sb * ic - xb;
        u32x4 w; w.x = cvt_pk_bf16(sa.x, sa.y); w.y = cvt_pk_bf16(sa.z, sa.w); w.z = cvt_pk_bf16(sb.x, sb.y); w.w = cvt_pk_bf16(sb.z, sb.w);
        *(LAS u32x4*)(lds + r * 400 + ch * 16) = w;
    }
    __syncthreads();
    const int fr = lane & 15, fq = lane >> 4;
    f32x4 acc[12];
#pragma unroll
    for (int d = 0; d < 12; ++d) acc[d] = (f32x4){0.f, 0.f, 0.f, 0.f};
    const LAS unsigned char* prow = lds + (16 * wave + fr) * 400 + fq * 16;
    const bf16_t* wbase = wpt + g * 192 * 192 + fr * 192 + fq * 8;
#pragma unroll
    for (int ks = 0; ks < 6; ++ks) { const bf16x8 pf = *(const LAS bf16x8*)(prow + ks * 64);
#pragma unroll
        for (int d = 0; d < 12; ++d) { const bf16x8 wf = *(const bf16x8*)(wbase + d * 16 * 192 + ks * 32); acc[d] = MFMA16(wf, pf, acc[d]); } }
    const int t = t0 + 16 * wave + fr;
#pragma unroll
    for (int d = 0; d < 12; ++d) { const int col = g * 192 + 16 * d + 4 * fq;
        const f32x4 sc = *(const f32x4*)(pscale + col); const u32x2 gg = *(const u32x2*)(ag + (size_t)t * BW + col);
        const f32x4 v = acc[d] * sc * (f32x4){bf_lo(gg.x), bf_hi(gg.x), bf_lo(gg.y), bf_hi(gg.y)};
        u32x2 w; w.x = cvt_pk_bf16(v.x, v.y); w.y = cvt_pk_bf16(v.z, v.w); *(u32x2*)(y0 + (size_t)t * BW + col) = w; }
    __syncthreads();
}

__device__ __forceinline__ void sgu_unit(LAS unsigned char* lds, int u, const bf16_t* cu, const bf16_t* cv, const bf16_t* cgt, const float* ng, const float* nb, const float* wsf, const float* bs, bf16_t* y2) {
    int tid = threadIdx.x; asm volatile("" : "+v"(tid)); const int lane = tid & 63, wave = __builtin_amdgcn_readfirstlane(tid >> 6);
    const int ci = u / 6, g = u - 6 * ci, t0 = ci * 128;
    LAS f32x2* stats = (LAS f32x2*)(lds + 34816);
    { const int q = tid >> 2, part = tid & 3; const u32x4* src = (const u32x4*)(cv + (size_t)(t0 + q) * BW + part * 192);
        float s = 0.f, s2 = 0.f;
#pragma unroll 6
        for (int i = 0; i < 24; ++i) { const u32x4 v = src[i];
            const float a0 = bf_lo(v.x), a1 = bf_hi(v.x), a2 = bf_lo(v.y), a3 = bf_hi(v.y), a4 = bf_lo(v.z), a5 = bf_hi(v.z), a6 = bf_lo(v.w), a7 = bf_hi(v.w);
            s += ((a0 + a1) + (a2 + a3)) + ((a4 + a5) + (a6 + a7)); s2 += ((a0 * a0 + a1 * a1) + (a2 * a2 + a3 * a3)) + ((a4 * a4 + a5 * a5) + (a6 * a6 + a7 * a7)); }
        s += __shfl_xor(s, 1); s += __shfl_xor(s, 2); s2 += __shfl_xor(s2, 1); s2 += __shfl_xor(s2, 2);
        const float mean = s * (1.f / BW); float var = s2 * (1.f / BW) - mean * mean; var = var > 0.f ? var : 0.f;
        if (part == 0) stats[q] = (f32x2){mean, 1.0f / sqrtf(var + EPS)};
    }
    __syncthreads();
#pragma unroll
    for (int it = 0; it < 4; ++it) { const int item = tid + NTHR * it, q = item & 127, chn = item >> 7;
        const f32x2 st = stats[q]; const u32x4 v = *(const u32x4*)(cv + (size_t)(t0 + q) * BW + g * 128 + chn * 8);
        const f32x4 ga = *(const f32x4*)(ng + g * 128 + chn * 8), gb = *(const f32x4*)(ng + g * 128 + chn * 8 + 4), ba = *(const f32x4*)(nb + g * 128 + chn * 8), bb = *(const f32x4*)(nb + g * 128 + chn * 8 + 4);
        f32x4 xa = {bf_lo(v.x), bf_hi(v.x), bf_lo(v.y), bf_hi(v.y)}, xb = {bf_lo(v.z), bf_hi(v.z), bf_lo(v.w), bf_hi(v.w)};
        xa = (xa - st.x) * st.y * ga + ba; xb = (xb - st.x) * st.y * gb + bb;
        const unsigned p0 = cvt_pk_bf16(xa.x, xa.y), p1 = cvt_pk_bf16(xa.z, xa.w), p2 = cvt_pk_bf16(xb.x, xb.y), p3 = cvt_pk_bf16(xb.z, xb.w);
        LAS unsigned short* dst = (LAS unsigned short*)(lds + (chn * 8) * 272 + q * 2);
        dst[0 * 136] = (unsigned short)p0; dst[1 * 136] = (unsigned short)(p0 >> 16); dst[2 * 136] = (unsigned short)p1; dst[3 * 136] = (unsigned short)(p1 >> 16);
        dst[4 * 136] = (unsigned short)p2; dst[5 * 136] = (unsigned short)(p2 >> 16); dst[6 * 136] = (unsigned short)p3; dst[7 * 136] = (unsigned short)(p3 >> 16);
    }
    __syncthreads();
    const int fr = lane & 15, fq = lane >> 4, pp = 16 * wave + fr;
    f32x4 acc[8];
#pragma unroll
    for (int c = 0; c < 8; ++c) acc[c] = (f32x4){0.f, 0.f, 0.f, 0.f};
#pragma unroll
    for (int ks = 0; ks < 4; ++ks) {
        if (32 * ks <= 16 * wave + 15) {
            const int q0 = 32 * ks + 8 * fq; const float* wp = wsf + (size_t)(g * 128 + pp) * 128 + q0;
            f32x4 a = *(const f32x4*)wp, b = *(const f32x4*)(wp + 4);
            a.x = (q0 + 0 <= pp) ? a.x : 0.f; a.y = (q0 + 1 <= pp) ? a.y : 0.f; a.z = (q0 + 2 <= pp) ? a.z : 0.f; a.w = (q0 + 3 <= pp) ? a.w : 0.f;
            b.x = (q0 + 4 <= pp) ? b.x : 0.f; b.y = (q0 + 5 <= pp) ? b.y : 0.f; b.z = (q0 + 6 <= pp) ? b.z : 0.f; b.w = (q0 + 7 <= pp) ? b.w : 0.f;
            u32x4 wv; wv.x = cvt_pk_bf16(a.x, a.y); wv.y = cvt_pk_bf16(a.z, a.w); wv.z = cvt_pk_bf16(b.x, b.y); wv.w = cvt_pk_bf16(b.z, b.w);
            const bf16x8 wf = mk8(wv);
#pragma unroll
            for (int c = 0; c < 8; ++c) { const bf16x8 vf = *(const LAS bf16x8*)(lds + (16 * c + fr) * 272 + q0 * 2); acc[c] = MFMA16(vf, wf, acc[c]); }
        }
    }
    const int t = t0 + pp; const float bias = bs[g * 128 + pp];
#pragma unroll
    for (int c = 0; c < 8; ++c) { const int col = g * 128 + 16 * c + 4 * fq;
        const u32x2 uu = *(const u32x2*)(cu + (size_t)t * BW + col), gg = *(const u32x2*)(cgt + (size_t)t * BW + col);
        const f32x4 v = (acc[c] + bias) * (f32x4){bf_lo(uu.x), bf_hi(uu.x), bf_lo(uu.y), bf_hi(uu.y)} * (f32x4){bf_lo(gg.x), bf_hi(gg.x), bf_lo(gg.y), bf_hi(gg.y)};
        u32x2 w; w.x = cvt_pk_bf16(v.x, v.y); w.y = cvt_pk_bf16(v.z, v.w); *(u32x2*)(y2 + (size_t)t * BW + col) = w; }
    __syncthreads();
}

constexpr int AK_STRIDE = 272, AV_STRIDE = 288, AK_BYTES = 64 * AK_STRIDE, AV_BYTES = 64 * AV_STRIDE, AV_OFF = 2 * AK_BYTES, ATBL_OFF = AV_OFF + 2 * AV_BYTES;
typedef short v4i16_t __attribute__((ext_vector_type(4)));
__device__ __forceinline__ s16x4 vtr(const LAS unsigned char* p) { return __builtin_bit_cast(s16x4, __builtin_amdgcn_ds_read_tr16_b64_v4i16((LAS v4i16_t*)p)); }

__device__ __forceinline__ void attn_unit(LAS unsigned char* lds, int bh, int qb, const bf16_t* Qs, const bf16_t* Ks, const bf16_t* Vs, const bf16_t* bg, const float* rel_bias, const float* lam, const float* subg, float lambda_init, bf16_t* y1) {
    int tid = threadIdx.x; asm volatile("" : "+v"(tid)); const int lane = tid & 63, wave = __builtin_amdgcn_readfirstlane(tid >> 6);
    const int b = bh / NH, h = bh - NH * b;
    const int fr = lane & 15, fq = lane >> 4;
    const int nt = 2 * qb + 2, jmax = 2 * qb + (wave >> 2), jnear = 2 * qb - 2;
    LAS float* tbl = (LAS float*)(lds + ATBL_OFF);
    { const int rel = tid - 256, n = rel < 0 ? -rel : rel;
      const int large = 8 + (n >= 12) + (n >= 16) + (n >= 23) + (n >= 32) + (n >= 46) + (n >= 64) + (n >= 91);
      const int bucket = (rel > 0 ? 16 : 0) + (n < 8 ? n : large);
      tbl[tid] = rel_bias[bucket * NH + h] * L2E; }
    const float c15 = rel_bias[15 * NH + h] * L2E;
    float lam_full;
    { const float a = lam[lane] * lam[64 + lane], c = lam[128 + lane] * lam[192 + lane]; lam_full = __expf(wave_sum(a)) - __expf(wave_sum(c)) + lambda_init; }
    const size_t rowbase = (size_t)b * SEQ;
    const int qpos = 128 * qb + 16 * wave + fr;
    bf16x8 qf[2][2];
    { const bf16_t* qp = Qs + (rowbase + qpos) * BW + h * 128 + fq * 8;
#pragma unroll
      for (int br = 0; br < 2; ++br)
#pragma unroll
          for (int ks = 0; ks < 2; ++ks) qf[br][ks] = *(const bf16x8*)(qp + br * 64 + ks * 32); }
    const int srow = tid >> 4, sch = tid & 15;
    const bf16_t* kg = Ks + (rowbase + srow) * BW + h * 128 + sch * 8;
    const bf16_t* vg = Vs + (rowbase + srow) * BW + h * 128 + sch * 8;
    u32x4 sk0, sk1, sv0, sv1;
    sk0 = *(const u32x4*)kg; sk1 = *(const u32x4*)(kg + 32 * BW); sv0 = *(const u32x4*)vg; sv1 = *(const u32x4*)(vg + 32 * BW);
    *(LAS u32x4*)(lds + srow * AK_STRIDE + sch * 16) = sk0; *(LAS u32x4*)(lds + (srow + 32) * AK_STRIDE + sch * 16) = sk1;
    *(LAS u32x4*)(lds + AV_OFF + srow * AV_STRIDE + sch * 16) = sv0; *(LAS u32x4*)(lds + AV_OFF + (srow + 32) * AV_STRIDE + sch * 16) = sv1;
    __syncthreads();
    f32x4 o1[8], o2[8];
#pragma unroll
    for (int d = 0; d < 8; ++d) { o1[d] = (f32x4){0.f, 0.f, 0.f, 0.f}; o2[d] = (f32x4){0.f, 0.f, 0.f, 0.f}; }
    float m1 = -1e30f, m2 = -1e30f, l1 = 0.f, l2 = 0.f;
    const float CS = 0.125f * L2E;
    const int kvoff = fr * AK_STRIDE + fq * 16;
    const int vvoff = (4 * fq + ((lane & 15) >> 2)) * AV_STRIDE + (lane & 3) * 8;
    for (int j = 0; j < nt; ++j) {
        const bool more = (j + 1 < nt);
        if (more) { const size_t adv = (size_t)(j + 1) * 64 * BW;
            sk0 = *(const u32x4*)(kg + adv); sk1 = *(const u32x4*)(kg + adv + 32 * BW); sv0 = *(const u32x4*)(vg + adv); sv1 = *(const u32x4*)(vg + adv + 32 * BW); }
        if (j <= jmax) {
            const LAS unsigned char* Kb = lds + (j & 1) * AK_BYTES + kvoff;
            const LAS unsigned char* Vb = lds + AV_OFF + (j & 1) * AV_BYTES + vvoff;
            f32x4 s1[4], s2[4];
#pragma unroll
            for (int kt = 0; kt < 4; ++kt) {
                const bf16x8 k00 = *(const LAS bf16x8*)(Kb + kt * 16 * AK_STRIDE), k01 = *(const LAS bf16x8*)(Kb + kt * 16 * AK_STRIDE + 64);
                const bf16x8 k10 = *(const LAS bf16x8*)(Kb + kt * 16 * AK_STRIDE + 128), k11 = *(const LAS bf16x8*)(Kb + kt * 16 * AK_STRIDE + 192);
                f32x4 z = {0.f, 0.f, 0.f, 0.f};
                s1[kt] = MFMA16(k00, qf[0][0], z); s1[kt] = MFMA16(k01, qf[0][1], s1[kt]);
                s2[kt] = MFMA16(k10, qf[1][0], z); s2[kt] = MFMA16(k11, qf[1][1], s2[kt]);
            }
            if (j >= jnear) {
                const int ib = 64 * j + 4 * fq - qpos + 256;
#pragma unroll
                for (int kt = 0; kt < 4; ++kt) {
                    const float b0 = tbl[ib + 16 * kt], b1 = tbl[ib + 16 * kt + 1], b2 = tbl[ib + 16 * kt + 2], b3 = tbl[ib + 16 * kt + 3];
                    s1[kt].x = s1[kt].x * CS + b0; s1[kt].y = s1[kt].y * CS + b1; s1[kt].z = s1[kt].z * CS + b2; s1[kt].w = s1[kt].w * CS + b3;
                    s2[kt].x = s2[kt].x * CS + b0; s2[kt].y = s2[kt].y * CS + b1; s2[kt].z = s2[kt].z * CS + b2; s2[kt].w = s2[kt].w * CS + b3;
                }
            } else {
#pragma unroll
                for (int kt = 0; kt < 4; ++kt) { s1[kt] = s1[kt] * CS + c15; s2[kt] = s2[kt] * CS + c15; }
            }
            float x1 = fmaxf(fmaxf(fmaxf(s1[0].x, s1[0].y), fmaxf(s1[0].z, s1[0].w)), fmaxf(fmaxf(s1[1].x, s1[1].y), fmaxf(s1[1].z, s1[1].w)));
            x1 = fmaxf(x1, fmaxf(fmaxf(fmaxf(s1[2].x, s1[2].y), fmaxf(s1[2].z, s1[2].w)), fmaxf(fmaxf(s1[3].x, s1[3].y), fmaxf(s1[3].z, s1[3].w))));
            float x2 = fmaxf(fmaxf(fmaxf(s2[0].x, s2[0].y), fmaxf(s2[0].z, s2[0].w)), fmaxf(fmaxf(s2[1].x, s2[1].y), fmaxf(s2[1].z, s2[1].w)));
            x2 = fmaxf(x2, fmaxf(fmaxf(fmaxf(s2[2].x, s2[2].y), fmaxf(s2[2].z, s2[2].w)), fmaxf(fmaxf(s2[3].x, s2[3].y), fmaxf(s2[3].z, s2[3].w))));
            x1 = fmaxf(x1, __shfl_xor(x1, 16)); x1 = fmaxf(x1, __shfl_xor(x1, 32));
            x2 = fmaxf(x2, __shfl_xor(x2, 16)); x2 = fmaxf(x2, __shfl_xor(x2, 32));
            const float mn1 = fmaxf(m1, x1), mn2 = fmaxf(m2, x2);
            const float al1 = __builtin_amdgcn_exp2f(m1 - mn1), al2 = __builtin_amdgcn_exp2f(m2 - mn2);
            m1 = mn1; m2 = mn2;
            float r1 = 0.f, r2 = 0.f;
#pragma unroll
            for (int kt = 0; kt < 4; ++kt) {
                s1[kt].x = __builtin_amdgcn_exp2f(s1[kt].x - mn1); s1[kt].y = __builtin_amdgcn_exp2f(s1[kt].y - mn1); s1[kt].z = __builtin_amdgcn_exp2f(s1[kt].z - mn1); s1[kt].w = __builtin_amdgcn_exp2f(s1[kt].w - mn1);
                s2[kt].x = __builtin_amdgcn_exp2f(s2[kt].x - mn2); s2[kt].y = __builtin_amdgcn_exp2f(s2[kt].y - mn2); s2[kt].z = __builtin_amdgcn_exp2f(s2[kt].z - mn2); s2[kt].w = __builtin_amdgcn_exp2f(s2[kt].w - mn2);
                r1 += (s1[kt].x + s1[kt].y) + (s1[kt].z + s1[kt].w); r2 += (s2[kt].x + s2[kt].y) + (s2[kt].z + s2[kt].w);
            }
            l1 = l1 * al1 + r1; l2 = l2 * al2 + r2;
#pragma unroll
            for (int d = 0; d < 8; ++d) { o1[d] = o1[d] * al1; o2[d] = o2[d] * al2; }
            bf16x8 p1[2], p2[2];
#pragma unroll
            for (int st = 0; st < 2; ++st) {
                u32x4 a; a.x = cvt_pk_bf16(s1[2 * st].x, s1[2 * st].y); a.y = cvt_pk_bf16(s1[2 * st].z, s1[2 * st].w); a.z = cvt_pk_bf16(s1[2 * st + 1].x, s1[2 * st + 1].y); a.w = cvt_pk_bf16(s1[2 * st + 1].z, s1[2 * st + 1].w);
                u32x4 c; c.x = cvt_pk_bf16(s2[2 * st].x, s2[2 * st].y); c.y = cvt_pk_bf16(s2[2 * st].z, s2[2 * st].w); c.z = cvt_pk_bf16(s2[2 * st + 1].x, s2[2 * st + 1].y); c.w = cvt_pk_bf16(s2[2 * st + 1].z, s2[2 * st + 1].w);
                p1[st] = mk8(a); p2[st] = mk8(c);
            }
#pragma unroll
            for (int d = 0; d < 8; ++d)
#pragma unroll
                for (int st = 0; st < 2; ++st) {
                    const s16x4 lo = vtr(Vb + (32 * st) * AV_STRIDE + d * 32), hi = vtr(Vb + (32 * st + 16) * AV_STRIDE + d * 32);
                    const bf16x8 vf = (bf16x8){lo[0], lo[1], lo[2], lo[3], hi[0], hi[1], hi[2], hi[3]};
                    o1[d] = MFMA16(vf, p1[st], o1[d]); o2[d] = MFMA16(vf, p2[st], o2[d]);
                }
        }
        if (more) { const int bo = ((j + 1) & 1);
            *(LAS u32x4*)(lds + bo * AK_BYTES + srow * AK_STRIDE + sch * 16) = sk0; *(LAS u32x4*)(lds + bo * AK_BYTES + (srow + 32) * AK_STRIDE + sch * 16) = sk1;
            *(LAS u32x4*)(lds + AV_OFF + bo * AV_BYTES + srow * AV_STRIDE + sch * 16) = sv0; *(LAS u32x4*)(lds + AV_OFF + bo * AV_BYTES + (srow + 32) * AV_STRIDE + sch * 16) = sv1; }
        __syncthreads();
    }
    l1 += __shfl_xor(l1, 16); l1 += __shfl_xor(l1, 32); l2 += __shfl_xor(l2, 16); l2 += __shfl_xor(l2, 32);
    const float i1 = 1.0f / l1, i2 = lam_full / l2;
    float ss = 0.f;
#pragma unroll
    for (int d = 0; d < 8; ++d) { o1[d] = o1[d] * i1 - o2[d] * i2; ss += dot4(o1[d]); }
    ss += __shfl_xor(ss, 16); ss += __shfl_xor(ss, 32);
    const float rs = (1.0f / sqrtf(ss * (1.f / 128.f) + EPS)) * (1.0f - lambda_init);
    const size_t t = rowbase + qpos;
#pragma unroll
    for (int d = 0; d < 8; ++d) { const int dv = 16 * d + 4 * fq; const int col = h * 128 + dv;
        const f32x4 sg = *(const f32x4*)(subg + dv); const u32x2 gg = *(const u32x2*)(bg + t * BW + col);
        const f32x4 v = o1[d] * rs * sg * (f32x4){bf_lo(gg.x), bf_hi(gg.x), bf_lo(gg.y), bf_hi(gg.y)};
        u32x2 w; w.x = cvt_pk_bf16(v.x, v.y); w.y = cvt_pk_bf16(v.z, v.w); *(u32x2*)(y1 + t * BW + col) = w; }
}

__global__ void __launch_bounds__(NTHR) mega_fwd(Params p) {
    extern __shared__ __attribute__((aligned(16))) unsigned char lds_raw[];
    cg::grid_group grid = cg::this_grid();
    LAS unsigned char* lds = (LAS unsigned char*)lds_raw;
    const int G = gridDim.x, bx = blockIdx.x;
    const int vcu = (G % 8 == 0) ? (bx % 8) * (G / 8) + bx / 8 : bx;
    unsigned char* ws = p.ws;
    bf16_t* H = (bf16_t*)(ws + WS_H); bf16_t* PROJ = (bf16_t*)(ws + WS_PROJ); bf16_t* GATES = (bf16_t*)(ws + WS_GATES); bf16_t* Y = (bf16_t*)(ws + WS_Y);
    bf16_t* MERGED = (bf16_t*)(ws + WS_MERGED); float* OUTB = (float*)(ws + WS_OUT);
    const size_t SEC = (size_t)M * BW;

    prologue(p, lds, vcu, G);
    grid.sync();

    for (int l = 0; l < DEPTH; ++l) {
        const float lambda_init = 0.8f - 0.6f * __expf(-0.3f * (float)l);
#ifndef NO_G1
        { pg8::Gemm g{H, (const bf16_t*)(ws + WS_W1T + l * SZ_W1T), M, N1, DM}; pg8::StaticOrder S; S.init(M, N1, G, bx);
          pg8::EpiG1 E{PROJ, GATES};
          pg8::gemm_phase<pg8::EpiG1, pg8::StaticOrder, true, true>(lds, g, S, E); }
#endif
        grid.sync();
        {
#ifndef NO_ATTN
          for (int r = 0;; ++r) { const int u = r * G + ((r & 1) ? (G - 1 - vcu) : vcu); if (u >= 384) break;
              attn_unit(lds, u % 12, 31 - u / 12, PROJ + 2 * SEC, PROJ + 3 * SEC, PROJ + 4 * SEC, PROJ + 5 * SEC, p.rel_bias, p.lam + l * 256, p.subln_g + l * 128, lambda_init, Y + SEC); }
#endif
#ifndef NO_POOL
          for (int u = vcu; u < 256; u += G)
              pool_unit(lds, u, PROJ, PROJ + SEC, (const bf16_t*)(ws + WS_WPT + l * SZ_WPT), p.pool_scale + l * BW, Y);
#endif
#ifndef NO_SGU
          for (int r = 0;; ++r) { const int u = r * G + ((r & 1) ? (G - 1 - vcu) : vcu); if (u >= 384) break;
              sgu_unit(lds, u, PROJ + 6 * SEC, PROJ + 7 * SEC, PROJ + 8 * SEC, p.sgu_ng + l * BW, p.sgu_nb + l * BW, p.sgu_w + (size_t)l * 6 * 128 * 128, p.sgu_b + l * 6 * 128, Y + 2 * SEC); }
#endif
        }
        grid.sync();
#ifndef NO_G2
        { pg8::Gemm g{Y, (const bf16_t*)(ws + WS_WBT + l * SZ_WBT), 3 * M, 3 * DM, BW}; pg8::G2Order S{G, vcu};
          pg8::EpiG2 E{GATES, OUTB, MERGED};
          pg8::gemm_phase<pg8::EpiG2, pg8::G2Order, true, true>(lds, g, S, E); }
#endif
        grid.sync();
#ifndef NO_G3
        { pg8::Gemm g{MERGED, (const bf16_t*)(ws + WS_WOT + l * SZ_WOT), M, DM, DM}; pg8::StaticOrder S; S.init(M, DM, G, bx);
          pg8::EpiG3 E{OUTB};
          pg8::gemm_phase<pg8::EpiG3, pg8::StaticOrder, true, true>(lds, g, S, E); }
#endif
        grid.sync();
        rowpass(l == 0 ? p.x : p.out, p.out, OUTB, p.g_post + l * DM, (l + 1 < DEPTH) ? p.g_pre + (l + 1) * DM : nullptr, H, vcu, G);
        if (l + 1 < DEPTH) grid.sync();
    }
}

extern "C" void kernel_launch(void* const* d_in, const int* in_sizes, int n_in, void* d_out, int out_size, void* d_ws, size_t ws_size, hipStream_t stream) {
    static int grid = 0;
    if (grid == 0) {
        if (n_in != 16 || in_sizes[0] != M * DM || out_size != M * DM || ws_size < WS_END) { fprintf(stderr, "kernel_launch: unexpected shapes / workspace (%zu < %zu); nothing launched\n", ws_size, (size_t)WS_END); grid = -1; return; }
        int dev = 0, cus = 0, per_cu = 0;
        hipGetDevice(&dev); hipDeviceGetAttribute(&cus, hipDeviceAttributeMultiprocessorCount, dev);
        if (hipFuncSetAttribute((const void*)mega_fwd, hipFuncAttributeMaxDynamicSharedMemorySize, LDS_BYTES) != hipSuccess) { fprintf(stderr, "kernel_launch: hipFuncSetAttribute failed\n"); grid = -1; return; }
        if (hipOccupancyMaxActiveBlocksPerMultiprocessor(&per_cu, (const void*)mega_fwd, NTHR, LDS_BYTES) != hipSuccess || per_cu < 1) { fprintf(stderr, "kernel_launch: occupancy query failed (%d)\n", per_cu); (void)hipGetLastError(); per_cu = 1; }
        grid = cus * per_cu;
    }
    if (grid < 0) return;
    Params p{};
    p.x = (const float*)d_in[0]; p.rel_bias = (const float*)d_in[1]; p.g_pre = (const float*)d_in[2]; p.w_in = (const float*)d_in[3]; p.w_gate = (const float*)d_in[4];
    p.pool_w = (const float*)d_in[5]; p.pool_scale = (const float*)d_in[6]; p.lam = (const float*)d_in[7]; p.subln_g = (const float*)d_in[8]; p.sgu_ng = (const float*)d_in[9];
    p.sgu_nb = (const float*)d_in[10]; p.sgu_w = (const float*)d_in[11]; p.sgu_b = (const float*)d_in[12]; p.w_branch = (const float*)d_in[13]; p.w_out = (const float*)d_in[14]; p.g_post = (const float*)d_in[15];
    p.out = (float*)d_out; p.ws = (unsigned char*)d_ws;
    void* args[] = {&p};
    hipError_t e = hipLaunchCooperativeKernel((const void*)mega_fwd, dim3(grid), dim3(NTHR), args, LDS_BYTES, stream);
    if (e != hipSuccess) fprintf(stderr, "cooperative launch failed: %s (grid %d)\n", hipGetErrorString(e), grid);
}
```

```cpp
#include <hip/hip_runtime.h>
#include <hip/hip_cooperative_groups.h>
#include <cstdio>
#include <cstdint>
namespace cg = cooperative_groups;
#ifndef REP_MASK
#define REP_MASK 0
#endif
namespace pg8 {
#define PG8_LAS __attribute__((address_space(3)))
typedef unsigned short bf16_t;
typedef short bf16x8 __attribute__((ext_vector_type(8)));
typedef float f32x4 __attribute__((ext_vector_type(4)));
typedef unsigned u32x4 __attribute__((ext_vector_type(4)));
constexpr int BM = 256, BK = 64, HALF = 128, HTB = HALF * BK * 2  , STAGE_BYTES = 8 * HTB, NXCD = 8, WGM = 8;

__host__ __device__ __forceinline__ int lds_byte(int r, int c) { const int st = (r >> 4) * 2 + (c >> 5), rr = r & 15, cc = c & 31, ob = rr * 64 + cc * 2; return st * 1024 + (ob ^ (((ob >> 9) & 1) << 5)); }
__host__ __device__ __forceinline__ void stage_rc(int b, int& R, int& C) { const int st = b / 1024, sb = b % 1024, swz = sb ^ (((sb >> 9) & 1) << 5); R = (st >> 1) * 16 + swz / 64; C = (st & 1) * 32 + (swz % 64) / 2; }
__host__ __device__ __forceinline__ int perm32(int rho) { const int n = rho >> 4, i = rho & 15; return 8 * (i >> 2) + 4 * n + (i & 3); }

struct Unit { int pm, pn; };
struct Gemm { const bf16_t* A; const bf16_t* Bt; int M, N, K; };

struct StaticOrder {
    int nM, nN, nwg, G, c;
    __host__ __device__ void init(int M, int N, int G_, int c_) { nM = M / BM; nN = N / BM; nwg = nM * nN; G = G_; c = c_; }
    __host__ __device__ bool next(int i, Unit& u) const {
        const long L = (long)i * G + c; if (L >= nwg) return false;
        int wgid = (int)L; { const int q = nwg / NXCD, r = nwg % NXCD, xcd = wgid % NXCD, off = wgid / NXCD; wgid = (xcd < r ? xcd * (q + 1) : r * (q + 1) + (xcd - r) * q) + off; }
        const int nig = WGM * nN, gid = wgid / nig, fm = gid * WGM, gsz = (nM - fm) < WGM ? (nM - fm) : WGM;
        u.pm = fm + ((wgid % nig) % gsz); u.pn = (wgid % nig) / gsz; return true;
    }
    __device__ __forceinline__ void a_ready(const Unit&) const {}
    __device__ __forceinline__ void done(const Unit&) const {}
};

__device__ __forceinline__ unsigned cvt_pk_bf16(float lo, float hi) { unsigned r; asm volatile("v_cvt_pk_bf16_f32 %0, %1, %2" : "=v"(r) : "v"(lo), "v"(hi)); return r; }
typedef float f32x2 __attribute__((ext_vector_type(2)));
__device__ __forceinline__ f32x2 gelu_pk(f32x2 v) {
    const f32x2 av = __builtin_elementwise_abs(v), d = av * 0.2316418882f + 1.0f;
    f32x2 t; t.x = __builtin_amdgcn_rcpf(d.x); t.y = __builtin_amdgcn_rcpf(d.y);
    f32x2 q = t * 0.5307027145f + (-0.7265760135f); q = q * t + 0.7107068705f; q = q * t + (-0.142248368f); q = q * t + 0.127414796f; q = q * t;
    const f32x2 s = (v * v) * (-0.72134752044f);
    f32x2 e; e.x = __builtin_amdgcn_exp2f(s.x); e.y = __builtin_amdgcn_exp2f(s.y);
    const f32x2 m = v * (q * e), r = v - m;
    f32x2 o; o.x = v.x < 0.f ? m.x : r.x; o.y = v.y < 0.f ? m.y : r.y; return o;
}


__device__ __forceinline__ float bf_lo(unsigned u) { return __uint_as_float(u << 16); }
__device__ __forceinline__ float bf_hi(unsigned u) { return __uint_as_float(u & 0xffff0000u); }
__device__ __forceinline__ float act_sig(float x, float na, float nb, bool mulx) {
    const float z = x * (na + nb * x * x);
    const float s = __builtin_amdgcn_rcpf(1.0f + __builtin_amdgcn_exp2f(z));
    return mulx ? x * s : fmaxf(s, 1e-18f);
}
constexpr int TOK = 8192, BRW = 768, NGATE = 6144, DMODEL = 2048;
struct EpiG1 {
    static constexpr bool PERM = true, AFTER_DRAIN = false, MID = false;
    bf16_t* proj; bf16_t* gates;
    __device__ __forceinline__ void operator()(const f32x4 (&acc)[2][2][4][2], const Unit& u, int wr, int wc, int fr, int fq) const {
        const int row0 = u.pm * BM + wr * 64 + fr; const int pn = u.pn;
        bf16_t* base; int ldc, colt, act;
        if (pn < 27) { const int s = pn / 3; base = proj + (size_t)s * TOK * BRW; ldc = BRW; colt = (pn - 3 * s) * BM; act = (s == 1 || s == 5 || s == 8) ? 1 : ((s == 6 || s == 7) ? 2 : 0); }
        else { base = gates; ldc = NGATE; colt = (pn - 27) * BM; act = 3; }
        const int col0 = colt + wc * 32 + 8 * fq;
        if (act == 0) {
#pragma unroll
            for (int ai = 0; ai < 2; ++ai)
#pragma unroll
                for (int m = 0; m < 4; ++m) { bf16_t* rowp = base + (size_t)(row0 + ai * HALF + m * 16) * ldc + col0;
#pragma unroll
                    for (int bj = 0; bj < 2; ++bj) { const f32x4 v0 = acc[ai][bj][m][0], v1 = acc[ai][bj][m][1];
                        u32x4 w; w.x = cvt_pk_bf16(v0[0], v0[1]); w.y = cvt_pk_bf16(v0[2], v0[3]); w.z = cvt_pk_bf16(v1[0], v1[1]); w.w = cvt_pk_bf16(v1[2], v1[3]);
                        *(u32x4*)(rowp + bj * HALF) = w; } }
        } else {
            const float L2E = 1.4426950408889634f;
            const float na = (act == 2) ? -L2E * 1.5957691216057308f : -L2E, nb = (act == 2) ? -L2E * 1.5957691216057308f * 0.044715f : 0.f; const bool mulx = (act != 3);
#pragma unroll
            for (int ai = 0; ai < 2; ++ai)
#pragma unroll
                for (int m = 0; m < 4; ++m) { bf16_t* rowp = base + (size_t)(row0 + ai * HALF + m * 16) * ldc + col0;
#pragma unroll
                    for (int bj = 0; bj < 2; ++bj) { const f32x4 v0 = acc[ai][bj][m][0], v1 = acc[ai][bj][m][1];
                        u32x4 w; w.x = cvt_pk_bf16(act_sig(v0[0], na, nb, mulx), act_sig(v0[1], na, nb, mulx)); w.y = cvt_pk_bf16(act_sig(v0[2], na, nb, mulx), act_sig(v0[3], na, nb, mulx));
                        w.z = cvt_pk_bf16(act_sig(v1[0], na, nb, mulx), act_sig(v1[1], na, nb, mulx)); w.w = cvt_pk_bf16(act_sig(v1[2], na, nb, mulx), act_sig(v1[3], na, nb, mulx));
                        *(u32x4*)(rowp + bj * HALF) = w; } }
        }
    }
};
struct EpiG2 {
    static constexpr bool PERM = true, AFTER_DRAIN = false, MID = false;
    const bf16_t* gates; float* part; bf16_t* merged;
    __device__ __forceinline__ void operator()(const f32x4 (&acc)[2][2][4][2], const Unit& u, int wr, int wc, int fr, int fq) const {
        const int n = u.pm >> 5, pm = u.pm & 31, pn = u.pn & 7;
        const int row0 = pm * BM + wr * 64 + fr, col0 = pn * BM + wc * 32 + 8 * fq;
#pragma unroll
        for (int ai = 0; ai < 2; ++ai)
#pragma unroll
            for (int m = 0; m < 4; ++m) { const size_t r = (size_t)(row0 + ai * HALF + m * 16);
#pragma unroll
                for (int bj = 0; bj < 2; ++bj) { const int c = col0 + bj * HALF;
                    const u32x4 g = *(const u32x4*)(gates + r * NGATE + n * DMODEL + c);
                    f32x4 v0 = acc[ai][bj][m][0], v1 = acc[ai][bj][m][1];
                    v0[0] *= bf_lo(g.x); v0[1] *= bf_hi(g.x); v0[2] *= bf_lo(g.y); v0[3] *= bf_hi(g.y); v1[0] *= bf_lo(g.z); v1[1] *= bf_hi(g.z); v1[2] *= bf_lo(g.w); v1[3] *= bf_hi(g.w);
                    float* pp = part + r * DMODEL + c;
                    if (n == 0) { *(f32x4*)pp = v0; *(f32x4*)(pp + 4) = v1; }
                    else { v0 += *(const f32x4*)pp; v1 += *(const f32x4*)(pp + 4);
                        if (n == 1) { *(f32x4*)pp = v0; *(f32x4*)(pp + 4) = v1; }
                        else { u32x4 w; w.x = cvt_pk_bf16(v0[0], v0[1]); w.y = cvt_pk_bf16(v0[2], v0[3]); w.z = cvt_pk_bf16(v1[0], v1[1]); w.w = cvt_pk_bf16(v1[2], v1[3]); *(u32x4*)(merged + r * DMODEL + c) = w; } }
                } }
    }
};
struct G2Order {
    int G, c;
    __device__ bool next(int i, Unit& u) const { const int k = i / 3, n = i - 3 * k; const int pr = c + k * G; if (pr >= 256) return false; u.pm = n * 32 + (pr >> 3); u.pn = n * 8 + (pr & 7); return true; }
    __device__ __forceinline__ void a_ready(const Unit&) const {}
    __device__ __forceinline__ void done(const Unit&) const {}
};
struct EpiG3 {
    static constexpr bool PERM = true, AFTER_DRAIN = false, MID = false;
    float* out;
    __device__ __forceinline__ void operator()(const f32x4 (&acc)[2][2][4][2], const Unit& u, int wr, int wc, int fr, int fq) const {
        const int row0 = u.pm * BM + wr * 64 + fr, col0 = u.pn * BM + wc * 32 + 8 * fq;
#pragma unroll
        for (int ai = 0; ai < 2; ++ai)
#pragma unroll
            for (int m = 0; m < 4; ++m) { float* rowp = out + (size_t)(row0 + ai * HALF + m * 16) * DMODEL + col0;
#pragma unroll
                for (int bj = 0; bj < 2; ++bj) { *(f32x4*)(rowp + bj * HALF) = acc[ai][bj][m][0]; *(f32x4*)(rowp + bj * HALF + 4) = acc[ai][bj][m][1]; } }
    }
};

struct EpiG2h {
    static constexpr bool PERM = true, AFTER_DRAIN = false, MID = true;
    const bf16_t* gates; bf16_t* merged;
    __device__ __forceinline__ void mid(f32x4 (&acc)[2][2][4][2], const Unit& u, int s, int wr, int wc, int fr, int fq) const {
        int row0 = u.pm * BM + wr * 64 + fr; const int col0 = u.pn * BM + wc * 32 + 8 * fq;
        asm volatile("" : "+v"(row0));
#pragma unroll
        for (int ai = 0; ai < 2; ++ai)
#pragma unroll
            for (int m = 0; m < 4; ++m) { const bf16_t* gp = gates + (size_t)(row0 + ai * HALF + m * 16) * NGATE + (s - 1) * DMODEL + col0;
#pragma unroll
                for (int bj = 0; bj < 2; ++bj) { const u32x4 a = *(const u32x4*)(gp + bj * HALF), b = *(const u32x4*)(gp + DMODEL + bj * HALF);
                    f32x4 r0, r1;
                    r0[0] = bf_lo(a.x) * __builtin_amdgcn_rcpf(bf_lo(b.x)); r0[1] = bf_hi(a.x) * __builtin_amdgcn_rcpf(bf_hi(b.x)); r0[2] = bf_lo(a.y) * __builtin_amdgcn_rcpf(bf_lo(b.y)); r0[3] = bf_hi(a.y) * __builtin_amdgcn_rcpf(bf_hi(b.y));
                    r1[0] = bf_lo(a.z) * __builtin_amdgcn_rcpf(bf_lo(b.z)); r1[1] = bf_hi(a.z) * __builtin_amdgcn_rcpf(bf_hi(b.z)); r1[2] = bf_lo(a.w) * __builtin_amdgcn_rcpf(bf_lo(b.w)); r1[3] = bf_hi(a.w) * __builtin_amdgcn_rcpf(bf_hi(b.w));
                    acc[ai][bj][m][0] *= r0; acc[ai][bj][m][1] *= r1; asm volatile("" ::: "memory"); } }
    }
    __device__ __forceinline__ void operator()(const f32x4 (&acc)[2][2][4][2], const Unit& u, int wr, int wc, int fr, int fq) const {
        const int row0 = u.pm * BM + wr * 64 + fr, col0 = u.pn * BM + wc * 32 + 8 * fq;
#pragma unroll
        for (int ai = 0; ai < 2; ++ai)
#pragma unroll
            for (int m = 0; m < 4; ++m) { const size_t r = (size_t)(row0 + ai * HALF + m * 16);
#pragma unroll
                for (int bj = 0; bj < 2; ++bj) { const int c = col0 + bj * HALF;
                    const u32x4 g = *(const u32x4*)(gates + r * NGATE + 2 * DMODEL + c);
                    const f32x4 v0 = acc[ai][bj][m][0], v1 = acc[ai][bj][m][1];
                    u32x4 w; w.x = cvt_pk_bf16(v0[0] * bf_lo(g.x), v0[1] * bf_hi(g.x)); w.y = cvt_pk_bf16(v0[2] * bf_lo(g.y), v0[3] * bf_hi(g.y));
                    w.z = cvt_pk_bf16(v1[0] * bf_lo(g.z), v1[1] * bf_hi(g.z)); w.w = cvt_pk_bf16(v1[2] * bf_lo(g.w), v1[3] * bf_hi(g.w));
                    *(u32x4*)(merged + r * DMODEL + c) = w; } }
    }
};
template <class Epi, class Sched, bool ALIGN_EPI = false, bool SP2 = false>
__device__ __forceinline__ void gemm_phase(PG8_LAS unsigned char* lds, const Gemm g, const Sched& S, const Epi& E) {
    int tid_ = threadIdx.x; asm volatile("" : "+v"(tid_));
    const int tid = tid_, wid = __builtin_amdgcn_readfirstlane(tid >> 6), lane = tid & 63, wr = wid >> 2, wc = wid & 3, fr = lane & 15, fq = lane >> 4;
    const int K = g.K, nt = K / BK;
    unsigned voffA[2], voffB[2];
#pragma unroll
    for (int i = 0; i < 2; ++i) { int R, C; stage_rc(tid * 16 + i * 8192, R, C); const int Rb = Epi::PERM ? ((R & ~31) + perm32(R & 31)) : R;
        voffA[i] = (unsigned)(R * K + C) * 2u; voffB[i] = (unsigned)(Rb * K + C) * 2u; }
    const size_t kstep = (size_t)(BK * 2);
    const size_t hstep = (size_t)HALF * K * 2;
    const size_t tstep = 2 * hstep;
    const unsigned ldsw = (unsigned)wid * 1024u;
    const int aoff = lds_byte(wr * 64 + fr, fq * 8), boff = lds_byte(wc * 32 + fr, fq * 8);
#define PG8_SA(b, h) (((b) * 2 + (h)) * HTB)
#define PG8_SB(b, h) ((4 + (b) * 2 + (h)) * HTB)
#define PG8_STAGE(bufoff, gbase, voff) do { _Pragma("unroll") for (int _i = 0; _i < 2; ++_i) \
        __builtin_amdgcn_global_load_lds((const unsigned*)((const char*)(gbase) + (voff)[_i]), (PG8_LAS unsigned*)(lds + (bufoff) + ldsw + _i * 8192), 16, 0, 0); } while (0)
#define PG8_LDA(dst, b, h) do { _Pragma("unroll") for (int m = 0; m < 4; ++m) _Pragma("unroll") for (int k = 0; k < 2; ++k) dst[m][k] = *(const PG8_LAS bf16x8*)(lds + PG8_SA(b, h) + aoff + m * 2048 + k * 1024); } while (0)
#define PG8_LDB(dst, b, h) do { _Pragma("unroll") for (int n = 0; n < 2; ++n) _Pragma("unroll") for (int k = 0; k < 2; ++k) dst[n][k] = *(const PG8_LAS bf16x8*)(lds + PG8_SB(b, h) + boff + n * 2048 + k * 1024); } while (0)
#define PG8_MMA(ai, bj, At, Bt) do { __builtin_amdgcn_s_setprio(1); _Pragma("unroll") for (int m = 0; m < 4; ++m) _Pragma("unroll") for (int n = 0; n < 2; ++n) _Pragma("unroll") for (int k = 0; k < 2; ++k) \
        acc[ai][bj][m][n] = __builtin_amdgcn_mfma_f32_16x16x32_bf16(Bt[n][k], At[m][k], acc[ai][bj][m][n], 0, 0, 0); __builtin_amdgcn_s_setprio(0); } while (0)
#define PG8_WAIT_V(n) asm volatile("s_waitcnt vmcnt(" #n ")" ::: "memory")
#define PG8_WAIT_L(n) asm volatile("s_waitcnt lgkmcnt(" #n ")" ::: "memory")
#define PG8_BAR __builtin_amdgcn_s_barrier()
#define PG8_SCHED __builtin_amdgcn_sched_barrier(0)
    Unit cur, nxt; int ui = 0;
    if (!S.next(0, cur)) return;
    f32x4 acc[2][2][4][2];
#pragma unroll
    for (int a = 0; a < 2; ++a)
#pragma unroll
        for (int b = 0; b < 2; ++b)
#pragma unroll
            for (int m = 0; m < 4; ++m)
#pragma unroll
                for (int n = 0; n < 2; ++n) acc[a][b][m][n] = (f32x4){0.f, 0.f, 0.f, 0.f};
    bf16x8 At[4][2], B0[2][2], B1[2][2];
    const char* cA = (const char*)g.A + (size_t)cur.pm * tstep; const char* cB = (const char*)g.Bt + (size_t)cur.pn * tstep;
    S.a_ready(cur);
    if constexpr (SP2) {
        PG8_STAGE(PG8_SB(0, 0), cB, voffB); PG8_STAGE(PG8_SB(0, 1), cB + hstep, voffB); PG8_STAGE(PG8_SA(0, 0), cA, voffA); PG8_STAGE(PG8_SA(0, 1), cA + hstep, voffA);
        if (wr == 1) PG8_BAR;
        PG8_WAIT_V(2); PG8_BAR;
        PG8_STAGE(PG8_SB(1, 0), cB + kstep, voffB); PG8_STAGE(PG8_SA(1, 0), cA + kstep, voffA); PG8_STAGE(PG8_SB(1, 1), cB + hstep + kstep, voffB);
        PG8_WAIT_V(6); PG8_BAR;
    } else {
        PG8_STAGE(PG8_SB(0, 0), cB, voffB); PG8_STAGE(PG8_SA(0, 0), cA, voffA); PG8_STAGE(PG8_SB(0, 1), cB + hstep, voffB); PG8_STAGE(PG8_SA(0, 1), cA + hstep, voffA);
        if (wr == 1) PG8_BAR;
        PG8_WAIT_V(4); PG8_BAR;
        PG8_STAGE(PG8_SB(1, 0), cB + kstep, voffB); PG8_STAGE(PG8_SA(1, 0), cA + kstep, voffA); PG8_STAGE(PG8_SB(1, 1), cB + hstep + kstep, voffB);
        PG8_WAIT_V(6); PG8_BAR;
    }
    for (;;) {
        const bool has_next = S.next(ui + 1, nxt);
        const char* nA = has_next ? (const char*)g.A + (size_t)nxt.pm * tstep : cA; const char* nB = has_next ? (const char*)g.Bt + (size_t)nxt.pn * tstep : cB;
        for (int t = 0; t < nt; t += 2) {
            if constexpr (Epi::MID) { if (t == 12 || t == 24) E.mid(acc, cur, t / 12, wr, wc, fr, fq); }
            const bool last = (t == nt - 2);
            const char* a1 = cA + (size_t)(t + 1) * kstep;
            const char* a2 = last ? nA : cA + (size_t)(t + 2) * kstep; const char* b2 = last ? nB : cB + (size_t)(t + 2) * kstep;
            const char* a3 = a2 + kstep; const char* b3 = b2 + kstep;
            if (last && has_next) S.a_ready(nxt);
            if constexpr (SP2) {
            PG8_LDB(B0, 0, 0); PG8_LDB(B1, 0, 1); PG8_SCHED; PG8_LDA(At, 0, 0); PG8_STAGE(PG8_SA(1, 1), a1 + hstep, voffA);
            PG8_WAIT_V(8); PG8_WAIT_L(0); PG8_BAR; PG8_MMA(0, 0, At, B0); PG8_MMA(0, 1, At, B1); PG8_BAR; PG8_SCHED;
            PG8_LDA(At, 0, 1); PG8_STAGE(PG8_SB(0, 0), b2, voffB); PG8_STAGE(PG8_SB(0, 1), b2 + hstep, voffB); PG8_STAGE(PG8_SA(0, 0), a2, voffA);
            PG8_WAIT_V(8); PG8_WAIT_L(0); PG8_BAR; PG8_MMA(1, 0, At, B0); PG8_MMA(1, 1, At, B1); PG8_BAR; PG8_SCHED;
            PG8_LDB(B0, 1, 0); PG8_LDB(B1, 1, 1); PG8_SCHED; PG8_LDA(At, 1, 0); PG8_STAGE(PG8_SA(0, 1), a2 + hstep, voffA);
            PG8_WAIT_V(8); PG8_WAIT_L(0); PG8_BAR; PG8_MMA(0, 0, At, B0); PG8_MMA(0, 1, At, B1); PG8_BAR; PG8_SCHED;
            PG8_LDA(At, 1, 1); PG8_STAGE(PG8_SB(1, 0), b3, voffB); PG8_STAGE(PG8_SB(1, 1), b3 + hstep, voffB); PG8_STAGE(PG8_SA(1, 0), a3, voffA);
            PG8_WAIT_V(8); PG8_WAIT_L(0); PG8_BAR; PG8_MMA(1, 0, At, B0); PG8_MMA(1, 1, At, B1); PG8_BAR; PG8_SCHED;
            } else {
            PG8_LDB(B0, 0, 0); PG8_SCHED; PG8_LDA(At, 0, 0); PG8_STAGE(PG8_SA(1, 1), a1 + hstep, voffA);
            PG8_WAIT_L(8); PG8_BAR; PG8_WAIT_L(0); PG8_MMA(0, 0, At, B0); PG8_BAR; PG8_SCHED;
            PG8_LDB(B1, 0, 1); PG8_STAGE(PG8_SB(0, 0), b2, voffB);
            PG8_BAR; PG8_WAIT_L(0); PG8_MMA(0, 1, At, B1); PG8_BAR;
            PG8_LDA(At, 0, 1); PG8_STAGE(PG8_SA(0, 0), a2, voffA);
            PG8_BAR; PG8_WAIT_L(0); PG8_MMA(1, 0, At, B0); PG8_BAR; PG8_SCHED;
            PG8_STAGE(PG8_SB(0, 1), b2 + hstep, voffB);
            PG8_WAIT_V(6); PG8_BAR; PG8_MMA(1, 1, At, B1); PG8_BAR;
            PG8_LDB(B0, 1, 0); PG8_SCHED; PG8_LDA(At, 1, 0); PG8_STAGE(PG8_SA(0, 1), a2 + hstep, voffA);
            PG8_WAIT_L(8); PG8_BAR; PG8_WAIT_L(0); PG8_MMA(0, 0, At, B0); PG8_BAR; PG8_SCHED;
            PG8_LDB(B1, 1, 1); PG8_STAGE(PG8_SB(1, 0), b3, voffB);
            PG8_BAR; PG8_WAIT_L(0); PG8_MMA(0, 1, At, B1); PG8_BAR;
            PG8_LDA(At, 1, 1); PG8_STAGE(PG8_SA(1, 0), a3, voffA);
            PG8_BAR; PG8_WAIT_L(0); PG8_MMA(1, 0, At, B0); PG8_BAR; PG8_SCHED;
            PG8_STAGE(PG8_SB(1, 1), b3 + hstep, voffB);
            PG8_WAIT_V(6); PG8_BAR; PG8_MMA(1, 1, At, B1); PG8_BAR;
            }
        }
        if constexpr (ALIGN_EPI) { if (wr == 0) PG8_BAR; }
        if constexpr (!Epi::AFTER_DRAIN) { E(acc, cur, wr, wc, fr, fq); S.done(cur); }
        if (!has_next) break;
#pragma unroll
        for (int a = 0; a < 2; ++a)
#pragma unroll
            for (int b = 0; b < 2; ++b)
#pragma unroll
                for (int m = 0; m < 4; ++m)
#pragma unroll
                    for (int n = 0; n < 2; ++n) acc[a][b][m][n] = (f32x4){0.f, 0.f, 0.f, 0.f};
        cur = nxt; cA = nA; cB = nB; ++ui;
        if constexpr (ALIGN_EPI) { if (wr == 1) PG8_BAR; }
    }
    PG8_WAIT_V(0);
    if constexpr (!ALIGN_EPI) { if (wr == 0) PG8_BAR; }
    PG8_BAR;
    if constexpr (Epi::AFTER_DRAIN) { E.fused(acc, cur, wr, wc, fr, fq, lds, wid, lane); S.done(cur); }
#undef PG8_SA
#undef PG8_SB
#undef PG8_STAGE
#undef PG8_LDA
#undef PG8_LDB
#undef PG8_MMA
#undef PG8_WAIT_V
#undef PG8_WAIT_L
#undef PG8_BAR
#undef PG8_SCHED
}
}

#ifndef PG8_SP2
#define PG8_SP2 true
#endif
#ifndef PG8_ALIGN
#define PG8_ALIGN true
#endif

#define LAS __attribute__((address_space(3)))
typedef unsigned short bf16_t;
typedef short bf16x8 __attribute__((ext_vector_type(8)));
typedef short s16x4 __attribute__((ext_vector_type(4)));
typedef float f32x4 __attribute__((ext_vector_type(4)));
typedef float f32x2 __attribute__((ext_vector_type(2)));
typedef unsigned u32x4 __attribute__((ext_vector_type(4)));
typedef unsigned u32x2 __attribute__((ext_vector_type(2)));
using pg8::cvt_pk_bf16; using pg8::bf_lo; using pg8::bf_hi;

constexpr int NB = 2, SEQ = 4096, DM = 2048, DEPTH = 4, M = NB * SEQ, BW = 768, DIN = 6912, NGT = 6144, N1 = DIN + NGT;
constexpr int NH = 6, YW = 3 * BW;
constexpr float EPS = 1e-6f, L2E = 1.4426950408889634f;
constexpr int NWAVES = 8, NTHR = 512;
constexpr int LDS_BYTES = 147456;

constexpr size_t SZ_W1T = (size_t)N1 * DM * 2, SZ_WBT = (size_t)3 * DM * BW * 2, SZ_WOT = (size_t)DM * DM * 2, SZ_WPT = (size_t)4 * 192 * 192 * 2;
constexpr size_t WS_W1T = 1u << 20;
constexpr size_t WS_WBT = WS_W1T + DEPTH * SZ_W1T;
constexpr size_t WS_WOT = WS_WBT + DEPTH * SZ_WBT;
constexpr size_t WS_WPT = WS_WOT + DEPTH * SZ_WOT;
constexpr size_t WS_H = (WS_WPT + DEPTH * SZ_WPT + 4095) & ~(size_t)4095;
constexpr size_t WS_PROJ = WS_H + (size_t)M * DM * 2;
constexpr size_t WS_GATES = WS_PROJ + (size_t)9 * M * BW * 2;
constexpr size_t WS_Y = WS_GATES + (size_t)M * NGT * 2;
constexpr size_t WS_MERGED = WS_Y + (size_t)3 * M * BW * 2;
constexpr size_t WS_OUT = WS_MERGED + (size_t)M * DM * 2;
constexpr size_t WS_END = WS_OUT + (size_t)M * DM * 4;

struct Params {
    const float *x, *rel_bias, *g_pre, *w_in, *w_gate, *pool_w, *pool_scale, *lam, *subln_g, *sgu_ng, *sgu_nb, *sgu_w, *sgu_b, *w_branch, *w_out, *g_post;
    float* out; unsigned char* ws;
};

__device__ __forceinline__ float wave_sum(float v) {
#pragma unroll
    for (int o = 1; o < 64; o <<= 1) v += __shfl_xor(v, o);
    return v;
}
__device__ __forceinline__ float dot4(f32x4 a) { return (a.x * a.x + a.y * a.y) + (a.z * a.z + a.w * a.w); }

__device__ __forceinline__ void transpose_item(const float* W, int K, int N, bf16_t* WT, int row_off, LAS float* scr, int item, int lane) {
    const int nblk = N / 32, kb = item / nblk, nb = item % nblk, k0 = 64 * kb, n0 = 32 * nb;
#pragma unroll 8
    for (int i = 0; i < 32; ++i) { const int kk = 2 * i + (lane >> 5); scr[kk * 33 + (lane & 31)] = W[(size_t)(k0 + kk) * N + n0 + (lane & 31)]; }
    asm volatile("s_waitcnt lgkmcnt(0)" ::: "memory");
    const int c = lane & 7;
#pragma unroll
    for (int j = 0; j < 4; ++j) { const int n = (lane >> 3) + 8 * j; const LAS float* s = scr + (8 * c) * 33 + n;
        u32x4 o; o.x = cvt_pk_bf16(s[0 * 33], s[1 * 33]); o.y = cvt_pk_bf16(s[2 * 33], s[3 * 33]); o.z = cvt_pk_bf16(s[4 * 33], s[5 * 33]); o.w = cvt_pk_bf16(s[6 * 33], s[7 * 33]);
        *(u32x4*)(WT + (size_t)(row_off + n0 + n) * K + k0 + 8 * c) = o; }
    asm volatile("s_waitcnt lgkmcnt(0)" ::: "memory");
}

__device__ __forceinline__ void rms_row_to_bf16(const float* xrow, const float* g, bf16_t* orow, int lane) {
    const f32x4* xr = (const f32x4*)xrow + lane; const f32x4* gr = (const f32x4*)g + lane;
    f32x4 v[8]; float s = 0.f;
#pragma unroll
    for (int j = 0; j < 8; ++j) { v[j] = xr[64 * j]; s += dot4(v[j]); }
    const float rstd = 1.0f / sqrtf(wave_sum(s) * (1.f / DM) + EPS);
    u32x2* o8 = (u32x2*)orow + lane;
#pragma unroll
    for (int j = 0; j < 8; ++j) { const f32x4 gg = gr[64 * j]; u32x2 w; w.x = cvt_pk_bf16(v[j].x * rstd * gg.x, v[j].y * rstd * gg.y); w.y = cvt_pk_bf16(v[j].z * rstd * gg.z, v[j].w * rstd * gg.w); o8[64 * j] = w; }
}

constexpr int I_IN = 32 * 216, I_G = 32 * 192, I_B1 = 12 * 64, I_B = 3 * I_B1, I_O = 32 * 64, I_P1 = 18, I_P = 4 * I_P1, I_LAYER = I_IN + I_G + I_B + I_O + I_P;

__device__ __forceinline__ void prologue(const Params& p, LAS unsigned char* lds, int vcu, int G) {
    int tid = threadIdx.x; asm volatile("" : "+v"(tid)); const int lane = tid & 63, wave = __builtin_amdgcn_readfirstlane(tid >> 6); const int gw = vcu * NWAVES + wave, NGW = G * NWAVES;
    LAS float* scr = (LAS float*)(lds + wave * 16384);
    unsigned char* ws = p.ws;
    for (int it = gw; it < DEPTH * I_LAYER; it += NGW) {
        const int l = it / I_LAYER; int r = it - l * I_LAYER;
        bf16_t* w1t = (bf16_t*)(ws + WS_W1T + l * SZ_W1T);
        if (r < I_IN) { transpose_item(p.w_in + (size_t)l * DM * DIN, DM, DIN, w1t, 0, scr, r, lane); continue; } r -= I_IN;
        if (r < I_G) { transpose_item(p.w_gate + (size_t)l * DM * NGT, DM, NGT, w1t, DIN, scr, r, lane); continue; } r -= I_G;
        if (r < I_B) { transpose_item(p.w_branch + (size_t)l * YW * DM, YW, DM, (bf16_t*)(ws + WS_WBT + l * SZ_WBT), 0, scr, r, lane); continue; } r -= I_B;
        if (r < I_O) { transpose_item(p.w_out + (size_t)l * DM * DM, DM, DM, (bf16_t*)(ws + WS_WOT + l * SZ_WOT), 0, scr, r, lane); continue; } r -= I_O;
        { const int g = r / I_P1, rr = r - g * I_P1; transpose_item(p.pool_w + (size_t)(l * 4 + g) * 192 * 192, 192, 192, (bf16_t*)(ws + WS_WPT + l * SZ_WPT) + g * 192 * 192, 0, scr, rr, lane); }
    }
    for (int m = gw; m < M; m += NGW) rms_row_to_bf16(p.x + (size_t)m * DM, p.g_pre, (bf16_t*)(ws + WS_H) + (size_t)m * DM, lane);
}

__device__ __forceinline__ void rowpass(const float* xin, float* xout, const float* outb, const float* gpost, const float* gnext, bf16_t* H, int vcu, int G) {
    int tid = threadIdx.x; asm volatile("" : "+v"(tid)); const int lane = tid & 63, wave = __builtin_amdgcn_readfirstlane(tid >> 6); const int gw = vcu * NWAVES + wave, NGW = G * NWAVES;
    for (int m = gw; m < M; m += NGW) {
        const f32x4* o4 = (const f32x4*)(outb + (size_t)m * DM) + lane; const f32x4* x4 = (const f32x4*)(xin + (size_t)m * DM) + lane;
        f32x4* xo = (f32x4*)(xout + (size_t)m * DM) + lane; const f32x4* gp = (const f32x4*)gpost + lane;
        f32x4 o[8]; float ss = 0.f;
#pragma unroll
        for (int j = 0; j < 8; ++j) { o[j] = o4[64 * j]; ss += dot4(o[j]); }
        const float rstd = 1.0f / sqrtf(wave_sum(ss) * (1.f / DM) + EPS);
        float s2 = 0.f;
#pragma unroll
        for (int j = 0; j < 8; ++j) { const f32x4 g = gp[64 * j]; const f32x4 xv = x4[64 * j]; o[j] = xv + o[j] * rstd * g; s2 += dot4(o[j]); xo[64 * j] = o[j]; }
        if (gnext) {
            const float r2 = 1.0f / sqrtf(wave_sum(s2) * (1.f / DM) + EPS);
            const f32x4* gn = (const f32x4*)gnext + lane; u32x2* h8 = (u32x2*)(H + (size_t)m * DM) + lane;
#pragma unroll
            for (int j = 0; j < 8; ++j) { const f32x4 g = gn[64 * j]; u32x2 w; w.x = cvt_pk_bf16(o[j].x * r2 * g.x, o[j].y * r2 * g.y); w.y = cvt_pk_bf16(o[j].z * r2 * g.z, o[j].w * r2 * g.w); h8[64 * j] = w; }
        }
    }
}

__device__ __forceinline__ bf16x8 mk8(u32x4 v) { return __builtin_bit_cast(bf16x8, v); }
#define MFMA16(a, b, c) __builtin_amdgcn_mfma_f32_16x16x32_bf16((a), (b), (c), 0, 0, 0)

__device__ __forceinline__ void pool_unit(LAS unsigned char* lds, int u, const bf16_t* ax, const bf16_t* ag, const bf16_t* wpt, const float* pscale, bf16_t* y0) {
    int tid = threadIdx.x; asm volatile("" : "+v"(tid)); const int lane = tid & 63, wave = __builtin_amdgcn_readfirstlane(tid >> 6);
    const int tt = u >> 2, g = u & 3, wl = 2 << g, t0 = tt * 128;
    for (int it = tid; it < 128 * 24; it += NTHR) {
        const int r = it / 24, ch = it - r * 24; const int t = t0 + r, ts = t & (SEQ - 1);
        const int cnt = (ts + 1 < wl) ? ts + 1 : wl;
        const bf16_t* src = ax + (size_t)t * BW + g * 192 + ch * 8;
        const u32x4 cur = *(const u32x4*)src;
        f32x4 xa = {bf_lo(cur.x), bf_hi(cur.x), bf_lo(cur.y), bf_hi(cur.y)}, xb = {bf_lo(cur.z), bf_hi(cur.z), bf_lo(cur.w), bf_hi(cur.w)};
        f32x4 sa = xa, sb = xb;
        for (int k = 1; k < cnt; ++k) { const u32x4 v = *(const u32x4*)(src - (size_t)k * BW);
            sa += (f32x4){bf_lo(v.x), bf_hi(v.x), bf_lo(v.y), bf_hi(v.y)}; sb += (f32x4){bf_lo(v.z), bf_hi(v.z), bf_lo(v.w), bf_hi(v.w)}; }
        const float ic = 1.0f / (float)cnt;
        sa = sa * ic - xa; sb = sb * ic - xb;
        u32x4 w; w.x = cvt_pk_bf16(sa.x, sa.y); w.y = cvt_pk_bf16(sa.z, sa.w); w.z = cvt_pk_bf16(sb.x, sb.y); w.w = cvt_pk_bf16(sb.z, sb.w);
        *(LAS u32x4*)(lds + r * 400 + ch * 16) = w;
    }
    __syncthreads();
    const int fr = lane & 15, fq = lane >> 4;
    f32x4 acc[12];
#pragma unroll
    for (int d = 0; d < 12; ++d) acc[d] = (f32x4){0.f, 0.f, 0.f, 0.f};
    const LAS unsigned char* prow = lds + (16 * wave + fr) * 400 + fq * 16;
    const bf16_t* wbase = wpt + g * 192 * 192 + fr * 192 + fq * 8;
#pragma unroll
    for (int ks = 0; ks < 6; ++ks) { const bf16x8 pf = *(const LAS bf16x8*)(prow + ks * 64);
#pragma unroll
        for (int d = 0; d < 12; ++d) { const bf16x8 wf = *(const bf16x8*)(wbase + d * 16 * 192 + ks * 32); acc[d] = MFMA16(wf, pf, acc[d]); } }
    const int t = t0 + 16 * wave + fr;
#pragma unroll
    for (int d = 0; d < 12; ++d) { const int col = g * 192 + 16 * d + 4 * fq;
        const f32x4 sc = *(const f32x4*)(pscale + col); const u32x2 gg = *(const u32x2*)(ag + (size_t)t * BW + col);
        const f32x4 v = acc[d] * sc * (f32x4){bf_lo(gg.x), bf_hi(gg.x), bf_lo(gg.y), bf_hi(gg.y)};
        u32x2 w; w.x = cvt_pk_bf16(v.x, v.y); w.y = cvt_pk_bf16(v.z, v.w); *(u32x2*)(y0 + (size_t)t * YW + col) = w; }
    __syncthreads();
}

__device__ __forceinline__ void sgu_unit(LAS unsigned char* lds, int u, const bf16_t* cu, const bf16_t* cv, const bf16_t* cgt, const float* ng, const float* nb, const float* wsf, const float* bs, bf16_t* y2) {
    int tid = threadIdx.x; asm volatile("" : "+v"(tid)); const int lane = tid & 63, wave = __builtin_amdgcn_readfirstlane(tid >> 6);
    const int ci = u / 6, g = u - 6 * ci, t0 = ci * 128;
    LAS f32x2* stats = (LAS f32x2*)(lds + 34816);
    { const int q = tid >> 2, part = tid & 3; const u32x4* src = (const u32x4*)(cv + (size_t)(t0 + q) * BW + part * 192);
        float s = 0.f, s2 = 0.f;
#pragma unroll 6
        for (int i = 0; i < 24; ++i) { const u32x4 v = src[i];
            const float a0 = bf_lo(v.x), a1 = bf_hi(v.x), a2 = bf_lo(v.y), a3 = bf_hi(v.y), a4 = bf_lo(v.z), a5 = bf_hi(v.z), a6 = bf_lo(v.w), a7 = bf_hi(v.w);
            s += ((a0 + a1) + (a2 + a3)) + ((a4 + a5) + (a6 + a7)); s2 += ((a0 * a0 + a1 * a1) + (a2 * a2 + a3 * a3)) + ((a4 * a4 + a5 * a5) + (a6 * a6 + a7 * a7)); }
        s += __shfl_xor(s, 1); s += __shfl_xor(s, 2); s2 += __shfl_xor(s2, 1); s2 += __shfl_xor(s2, 2);
        const float mean = s * (1.f / BW); float var = s2 * (1.f / BW) - mean * mean; var = var > 0.f ? var : 0.f;
        if (part == 0) stats[q] = (f32x2){mean, 1.0f / sqrtf(var + EPS)};
    }
    __syncthreads();
#pragma unroll
    for (int it = 0; it < 4; ++it) { const int item = tid + NTHR * it, q = item & 127, chn = item >> 7;
        const f32x2 st = stats[q]; const u32x4 v = *(const u32x4*)(cv + (size_t)(t0 + q) * BW + g * 128 + chn * 8);
        const f32x4 ga = *(const f32x4*)(ng + g * 128 + chn * 8), gb = *(const f32x4*)(ng + g * 128 + chn * 8 + 4), ba = *(const f32x4*)(nb + g * 128 + chn * 8), bb = *(const f32x4*)(nb + g * 128 + chn * 8 + 4);
        f32x4 xa = {bf_lo(v.x), bf_hi(v.x), bf_lo(v.y), bf_hi(v.y)}, xb = {bf_lo(v.z), bf_hi(v.z), bf_lo(v.w), bf_hi(v.w)};
        xa = (xa - st.x) * st.y * ga + ba; xb = (xb - st.x) * st.y * gb + bb;
        const unsigned p0 = cvt_pk_bf16(xa.x, xa.y), p1 = cvt_pk_bf16(xa.z, xa.w), p2 = cvt_pk_bf16(xb.x, xb.y), p3 = cvt_pk_bf16(xb.z, xb.w);
        LAS unsigned short* dst = (LAS unsigned short*)(lds + (chn * 8) * 272 + q * 2);
        dst[0 * 136] = (unsigned short)p0; dst[1 * 136] = (unsigned short)(p0 >> 16); dst[2 * 136] = (unsigned short)p1; dst[3 * 136] = (unsigned short)(p1 >> 16);
        dst[4 * 136] = (unsigned short)p2; dst[5 * 136] = (unsigned short)(p2 >> 16); dst[6 * 136] = (unsigned short)p3; dst[7 * 136] = (unsigned short)(p3 >> 16);
    }
    __syncthreads();
    const int fr = lane & 15, fq = lane >> 4, pp = 16 * wave + fr;
    f32x4 acc[8];
#pragma unroll
    for (int c = 0; c < 8; ++c) acc[c] = (f32x4){0.f, 0.f, 0.f, 0.f};
#pragma unroll
    for (int ks = 0; ks < 4; ++ks) {
        if (32 * ks <= 16 * wave + 15) {
            const int q0 = 32 * ks + 8 * fq; const float* wp = wsf + (size_t)(g * 128 + pp) * 128 + q0;
            f32x4 a = *(const f32x4*)wp, b = *(const f32x4*)(wp + 4);
            a.x = (q0 + 0 <= pp) ? a.x : 0.f; a.y = (q0 + 1 <= pp) ? a.y : 0.f; a.z = (q0 + 2 <= pp) ? a.z : 0.f; a.w = (q0 + 3 <= pp) ? a.w : 0.f;
            b.x = (q0 + 4 <= pp) ? b.x : 0.f; b.y = (q0 + 5 <= pp) ? b.y : 0.f; b.z = (q0 + 6 <= pp) ? b.z : 0.f; b.w = (q0 + 7 <= pp) ? b.w : 0.f;
            u32x4 wv; wv.x = cvt_pk_bf16(a.x, a.y); wv.y = cvt_pk_bf16(a.z, a.w); wv.z = cvt_pk_bf16(b.x, b.y); wv.w = cvt_pk_bf16(b.z, b.w);
            const bf16x8 wf = mk8(wv);
#pragma unroll
            for (int c = 0; c < 8; ++c) { const bf16x8 vf = *(const LAS bf16x8*)(lds + (16 * c + fr) * 272 + q0 * 2); acc[c] = MFMA16(vf, wf, acc[c]); }
        }
    }
    const int t = t0 + pp; const float bias = bs[g * 128 + pp];
#pragma unroll
    for (int c = 0; c < 8; ++c) { const int col = g * 128 + 16 * c + 4 * fq;
        const u32x2 uu = *(const u32x2*)(cu + (size_t)t * BW + col), gg = *(const u32x2*)(cgt + (size_t)t * BW + col);
        const f32x4 v = (acc[c] + bias) * (f32x4){bf_lo(uu.x), bf_hi(uu.x), bf_lo(uu.y), bf_hi(uu.y)} * (f32x4){bf_lo(gg.x), bf_hi(gg.x), bf_lo(gg.y), bf_hi(gg.y)};
        u32x2 w; w.x = cvt_pk_bf16(v.x, v.y); w.y = cvt_pk_bf16(v.z, v.w); *(u32x2*)(y2 + (size_t)t * YW + col) = w; }
    __syncthreads();
}

constexpr int AK_STRIDE = 272, AV_STRIDE = 288, AK_BYTES = 64 * AK_STRIDE, AV_BYTES = 64 * AV_STRIDE, AV_OFF = 2 * AK_BYTES, ATBL_OFF = AV_OFF + 2 * AV_BYTES;
typedef short v4i16_t __attribute__((ext_vector_type(4)));
__device__ __forceinline__ s16x4 vtr(const LAS unsigned char* p) { return __builtin_bit_cast(s16x4, __builtin_amdgcn_ds_read_tr16_b64_v4i16((LAS v4i16_t*)p)); }

__device__ __forceinline__ void attn_unit(LAS unsigned char* lds, int bh, int qb, const bf16_t* Qs, const bf16_t* Ks, const bf16_t* Vs, const bf16_t* bg, const float* rel_bias, const float* lam, const float* subg, float lambda_init, bf16_t* y1) {
    int tid = threadIdx.x; asm volatile("" : "+v"(tid)); const int lane = tid & 63, wave = __builtin_amdgcn_readfirstlane(tid >> 6);
    const int b = bh / NH, h = bh - NH * b;
    const int fr = lane & 15, fq = lane >> 4;
    const int nt = 2 * qb + 2, jmax = 2 * qb + (wave >> 2), jnear = 2 * qb - 2;
    LAS float* tbl = (LAS float*)(lds + ATBL_OFF);
    { const int rel = tid - 256, n = rel < 0 ? -rel : rel;
      const int large = 8 + (n >= 12) + (n >= 16) + (n >= 23) + (n >= 32) + (n >= 46) + (n >= 64) + (n >= 91);
      const int bucket = (rel > 0 ? 16 : 0) + (n < 8 ? n : large);
      tbl[tid] = rel_bias[bucket * NH + h] * L2E; }
    const float c15 = rel_bias[15 * NH + h] * L2E;
    float lam_full;
    { const float a = lam[lane] * lam[64 + lane], c = lam[128 + lane] * lam[192 + lane]; lam_full = __expf(wave_sum(a)) - __expf(wave_sum(c)) + lambda_init; }
    const size_t rowbase = (size_t)b * SEQ;
    const int qpos = 128 * qb + 16 * wave + fr;
    bf16x8 qf[2][2];
    { const bf16_t* qp = Qs + (rowbase + qpos) * BW + h * 128 + fq * 8;
#pragma unroll
      for (int br = 0; br < 2; ++br)
#pragma unroll
          for (int ks = 0; ks < 2; ++ks) qf[br][ks] = *(const bf16x8*)(qp + br * 64 + ks * 32); }
    const int srow = tid >> 4, sch = tid & 15;
    const bf16_t* kg = Ks + (rowbase + srow) * BW + h * 128 + sch * 8;
    const bf16_t* vg = Vs + (rowbase + srow) * BW + h * 128 + sch * 8;
    u32x4 sk0, sk1, sv0, sv1;
    sk0 = *(const u32x4*)kg; sk1 = *(const u32x4*)(kg + 32 * BW); sv0 = *(const u32x4*)vg; sv1 = *(const u32x4*)(vg + 32 * BW);
    *(LAS u32x4*)(lds + srow * AK_STRIDE + sch * 16) = sk0; *(LAS u32x4*)(lds + (srow + 32) * AK_STRIDE + sch * 16) = sk1;
    *(LAS u32x4*)(lds + AV_OFF + srow * AV_STRIDE + sch * 16) = sv0; *(LAS u32x4*)(lds + AV_OFF + (srow + 32) * AV_STRIDE + sch * 16) = sv1;
    __syncthreads();
    f32x4 o1[8], o2[8];
#pragma unroll
    for (int d = 0; d < 8; ++d) { o1[d] = (f32x4){0.f, 0.f, 0.f, 0.f}; o2[d] = (f32x4){0.f, 0.f, 0.f, 0.f}; }
    float m1 = -1e30f, m2 = -1e30f, l1 = 0.f, l2 = 0.f;
    const float CS = 0.125f * L2E;
    const int kvoff = fr * AK_STRIDE + fq * 16;
    const int vvoff = (4 * fq + ((lane & 15) >> 2)) * AV_STRIDE + (lane & 3) * 8;
    for (int j = 0; j < nt; ++j) {
        const bool more = (j + 1 < nt);
        if (more) { const size_t adv = (size_t)(j + 1) * 64 * BW;
            sk0 = *(const u32x4*)(kg + adv); sk1 = *(const u32x4*)(kg + adv + 32 * BW); sv0 = *(const u32x4*)(vg + adv); sv1 = *(const u32x4*)(vg + adv + 32 * BW); }
        if (j <= jmax) {
            const LAS unsigned char* Kb = lds + (j & 1) * AK_BYTES + kvoff;
            const LAS unsigned char* Vb = lds + AV_OFF + (j & 1) * AV_BYTES + vvoff;
            f32x4 s1[4], s2[4];
#pragma unroll
            for (int kt = 0; kt < 4; ++kt) {
                const bf16x8 k00 = *(const LAS bf16x8*)(Kb + kt * 16 * AK_STRIDE), k01 = *(const LAS bf16x8*)(Kb + kt * 16 * AK_STRIDE + 64);
                const bf16x8 k10 = *(const LAS bf16x8*)(Kb + kt * 16 * AK_STRIDE + 128), k11 = *(const LAS bf16x8*)(Kb + kt * 16 * AK_STRIDE + 192);
                f32x4 z = {0.f, 0.f, 0.f, 0.f};
                s1[kt] = MFMA16(k00, qf[0][0], z); s1[kt] = MFMA16(k01, qf[0][1], s1[kt]);
                s2[kt] = MFMA16(k10, qf[1][0], z); s2[kt] = MFMA16(k11, qf[1][1], s2[kt]);
            }
            if (j >= jnear) {
                const int ib = 64 * j + 4 * fq - qpos + 256;
#pragma unroll
                for (int kt = 0; kt < 4; ++kt) {
                    const float b0 = tbl[ib + 16 * kt], b1 = tbl[ib + 16 * kt + 1], b2 = tbl[ib + 16 * kt + 2], b3 = tbl[ib + 16 * kt + 3];
                    s1[kt].x = s1[kt].x * CS + b0; s1[kt].y = s1[kt].y * CS + b1; s1[kt].z = s1[kt].z * CS + b2; s1[kt].w = s1[kt].w * CS + b3;
                    s2[kt].x = s2[kt].x * CS + b0; s2[kt].y = s2[kt].y * CS + b1; s2[kt].z = s2[kt].z * CS + b2; s2[kt].w = s2[kt].w * CS + b3;
                }
            } else {
#pragma unroll
                for (int kt = 0; kt < 4; ++kt) { s1[kt] = s1[kt] * CS + c15; s2[kt] = s2[kt] * CS + c15; }
            }
            float x1 = fmaxf(fmaxf(fmaxf(s1[0].x, s1[0].y), fmaxf(s1[0].z, s1[0].w)), fmaxf(fmaxf(s1[1].x, s1[1].y), fmaxf(s1[1].z, s1[1].w)));
            x1 = fmaxf(x1, fmaxf(fmaxf(fmaxf(s1[2].x, s1[2].y), fmaxf(s1[2].z, s1[2].w)), fmaxf(fmaxf(s1[3].x, s1[3].y), fmaxf(s1[3].z, s1[3].w))));
            float x2 = fmaxf(fmaxf(fmaxf(s2[0].x, s2[0].y), fmaxf(s2[0].z, s2[0].w)), fmaxf(fmaxf(s2[1].x, s2[1].y), fmaxf(s2[1].z, s2[1].w)));
            x2 = fmaxf(x2, fmaxf(fmaxf(fmaxf(s2[2].x, s2[2].y), fmaxf(s2[2].z, s2[2].w)), fmaxf(fmaxf(s2[3].x, s2[3].y), fmaxf(s2[3].z, s2[3].w))));
            x1 = fmaxf(x1, __shfl_xor(x1, 16)); x1 = fmaxf(x1, __shfl_xor(x1, 32));
            x2 = fmaxf(x2, __shfl_xor(x2, 16)); x2 = fmaxf(x2, __shfl_xor(x2, 32));
            const float mn1 = fmaxf(m1, x1), mn2 = fmaxf(m2, x2);
            const float al1 = __builtin_amdgcn_exp2f(m1 - mn1), al2 = __builtin_amdgcn_exp2f(m2 - mn2);
            m1 = mn1; m2 = mn2;
            float r1 = 0.f, r2 = 0.f;
#pragma unroll
            for (int kt = 0; kt < 4; ++kt) {
                s1[kt].x = __builtin_amdgcn_exp2f(s1[kt].x - mn1); s1[kt].y = __builtin_amdgcn_exp2f(s1[kt].y - mn1); s1[kt].z = __builtin_amdgcn_exp2f(s1[kt].z - mn1); s1[kt].w = __builtin_amdgcn_exp2f(s1[kt].w - mn1);
                s2[kt].x = __builtin_amdgcn_exp2f(s2[kt].x - mn2); s2[kt].y = __builtin_amdgcn_exp2f(s2[kt].y - mn2); s2[kt].z = __builtin_amdgcn_exp2f(s2[kt].z - mn2); s2[kt].w = __builtin_amdgcn_exp2f(s2[kt].w - mn2);
                r1 += (s1[kt].x + s1[kt].y) + (s1[kt].z + s1[kt].w); r2 += (s2[kt].x + s2[kt].y) + (s2[kt].z + s2[kt].w);
            }
            l1 = l1 * al1 + r1; l2 = l2 * al2 + r2;
#pragma unroll
            for (int d = 0; d < 8; ++d) { o1[d] = o1[d] * al1; o2[d] = o2[d] * al2; }
            bf16x8 p1[2], p2[2];
#pragma unroll
            for (int st = 0; st < 2; ++st) {
                u32x4 a; a.x = cvt_pk_bf16(s1[2 * st].x, s1[2 * st].y); a.y = cvt_pk_bf16(s1[2 * st].z, s1[2 * st].w); a.z = cvt_pk_bf16(s1[2 * st + 1].x, s1[2 * st + 1].y); a.w = cvt_pk_bf16(s1[2 * st + 1].z, s1[2 * st + 1].w);
                u32x4 c; c.x = cvt_pk_bf16(s2[2 * st].x, s2[2 * st].y); c.y = cvt_pk_bf16(s2[2 * st].z, s2[2 * st].w); c.z = cvt_pk_bf16(s2[2 * st + 1].x, s2[2 * st + 1].y); c.w = cvt_pk_bf16(s2[2 * st + 1].z, s2[2 * st + 1].w);
                p1[st] = mk8(a); p2[st] = mk8(c);
            }
#pragma unroll
            for (int d = 0; d < 8; ++d)
#pragma unroll
                for (int st = 0; st < 2; ++st) {
                    const s16x4 lo = vtr(Vb + (32 * st) * AV_STRIDE + d * 32), hi = vtr(Vb + (32 * st + 16) * AV_STRIDE + d * 32);
                    const bf16x8 vf = (bf16x8){lo[0], lo[1], lo[2], lo[3], hi[0], hi[1], hi[2], hi[3]};
                    o1[d] = MFMA16(vf, p1[st], o1[d]); o2[d] = MFMA16(vf, p2[st], o2[d]);
                }
        }
        if (more) { const int bo = ((j + 1) & 1);
            *(LAS u32x4*)(lds + bo * AK_BYTES + srow * AK_STRIDE + sch * 16) = sk0; *(LAS u32x4*)(lds + bo * AK_BYTES + (srow + 32) * AK_STRIDE + sch * 16) = sk1;
            *(LAS u32x4*)(lds + AV_OFF + bo * AV_BYTES + srow * AV_STRIDE + sch * 16) = sv0; *(LAS u32x4*)(lds + AV_OFF + bo * AV_BYTES + (srow + 32) * AV_STRIDE + sch * 16) = sv1; }
        __syncthreads();
    }
    l1 += __shfl_xor(l1, 16); l1 += __shfl_xor(l1, 32); l2 += __shfl_xor(l2, 16); l2 += __shfl_xor(l2, 32);
    const float i1 = 1.0f / l1, i2 = lam_full / l2;
    float ss = 0.f;
#pragma unroll
    for (int d = 0; d < 8; ++d) { o1[d] = o1[d] * i1 - o2[d] * i2; ss += dot4(o1[d]); }
    ss += __shfl_xor(ss, 16); ss += __shfl_xor(ss, 32);
    const float rs = (1.0f / sqrtf(ss * (1.f / 128.f) + EPS)) * (1.0f - lambda_init);
    const size_t t = rowbase + qpos;
#pragma unroll
    for (int d = 0; d < 8; ++d) { const int dv = 16 * d + 4 * fq; const int col = h * 128 + dv;
        const f32x4 sg = *(const f32x4*)(subg + dv); const u32x2 gg = *(const u32x2*)(bg + t * BW + col);
        const f32x4 v = o1[d] * rs * sg * (f32x4){bf_lo(gg.x), bf_hi(gg.x), bf_lo(gg.y), bf_hi(gg.y)};
        u32x2 w; w.x = cvt_pk_bf16(v.x, v.y); w.y = cvt_pk_bf16(v.z, v.w); *(u32x2*)(y1 + t * YW + col) = w; }
}

#define XB_TMO      128
#define XB_XCNT(j)  (256  + 64 * (j))
#define XB_XSUB(j)  (1280 + 64 * (j))
#define XB_XGEN(j)  (2304 + 64 * (j))
#define XB_TOP      3328
#define XB_TOPGEN   3392
#define XCD_BAR_WORDS 3456
#define XB_SPIN_CAP (1u << 18)

__device__ __forceinline__ unsigned xb_ld(unsigned* p)              { return __hip_atomic_load(p, __ATOMIC_RELAXED, __HIP_MEMORY_SCOPE_AGENT); }
__device__ __forceinline__ unsigned xb_add(unsigned* p, unsigned v) { return __hip_atomic_fetch_add(p, v, __ATOMIC_RELAXED, __HIP_MEMORY_SCOPE_AGENT); }
__device__ __forceinline__ unsigned xb_xcc_id() { return (unsigned)__builtin_amdgcn_s_getreg((3 << 11) | 20) & 0xFu; }
#define XB_SPIN(cond, bar) do { unsigned _sp = 0; while (cond) { __builtin_amdgcn_s_sleep(1); \
    if ((++_sp & 255u) == 0u) { if (xb_ld(&(bar)[XB_TMO])) break; if (_sp > XB_SPIN_CAP) { atomicAdd(&(bar)[XB_TMO], 1u); break; } } } } while (0)

struct XcdBarrier {
    unsigned* bar; unsigned x;
    volatile LAS unsigned* st;
};

__device__ __forceinline__ XcdBarrier xcd_barrier_post(unsigned* bar, volatile LAS unsigned* st) {
    XcdBarrier b; b.bar = bar; b.x = xb_xcc_id(); b.st = st;
    if (threadIdx.x == 0) (void)xb_add(&bar[XB_XCNT(b.x)], 1u);
    return b;
}
__device__ __forceinline__ void xcd_barrier_complete(unsigned* bar, unsigned x, unsigned& nloc, unsigned& nx) {
    const unsigned G = gridDim.x * gridDim.y * gridDim.z;
    unsigned sum, cnt, mine, sp = 0u;
    for (;;) {
        sum = 0u; cnt = 0u; mine = 0u;
#pragma unroll
        for (unsigned j = 0; j < 16; ++j) { const unsigned c = xb_ld(&bar[XB_XCNT(j)]); sum += c; cnt += (c > 0u) ? 1u : 0u; mine = (j == x) ? c : mine; }
        if (sum == G) break;
        __builtin_amdgcn_s_sleep(1);
        if ((++sp & 255u) == 0u) { if (xb_ld(&bar[XB_TMO])) break; if (sp > XB_SPIN_CAP) { atomicAdd(&bar[XB_TMO], 1u); break; } }
    }
    nloc = mine > 0u ? mine : 1u; nx = cnt > 0u ? cnt : 1u;
}

__device__ __forceinline__ void xcd_barrier(const XcdBarrier& b) {
    asm volatile("s_waitcnt vmcnt(0)" ::: "memory");
    __syncthreads();
    if (threadIdx.x == 0) {
        unsigned* bar = b.bar;
        __builtin_amdgcn_s_waitcnt(0);
        unsigned nloc = b.st[0], nx = b.st[1];
        if (nloc == 0u) { xcd_barrier_complete(bar, b.x, nloc, nx); b.st[0] = nloc; b.st[1] = nx; }
        const unsigned old = xb_add(&bar[XB_XSUB(b.x)], 1u);
        const unsigned gen = old / nloc;
        if (old + 1u == (gen + 1u) * nloc) {
            __builtin_amdgcn_fence(__ATOMIC_RELEASE, "agent");
            asm volatile("s_waitcnt vmcnt(0)" ::: "memory");
            const unsigned og = xb_add(&bar[XB_TOP], 1u);
            const unsigned tg = og / nx;
            if (og + 1u == (tg + 1u) * nx) xb_add(&bar[XB_TOPGEN], 1u);
            else XB_SPIN(xb_ld(&bar[XB_TOPGEN]) == tg, bar);
            __builtin_amdgcn_fence(__ATOMIC_ACQUIRE, "agent");
            xb_add(&bar[XB_XGEN(b.x)], 1u);
            asm volatile("s_waitcnt vmcnt(0)" ::: "memory");
        } else {
            XB_SPIN(xb_ld(&bar[XB_XGEN(b.x)]) == gen, bar);
            __builtin_amdgcn_fence(__ATOMIC_ACQUIRE, "agent");
            asm volatile("s_waitcnt vmcnt(0)" ::: "memory");
        }
    }
    __syncthreads();
}

#define GSYNC() do { xcd_barrier(xb); if (REP_MASK & 16) xcd_barrier(xb); } while (0)
constexpr int MISC_OFF = 131072 + 256;
#ifndef DEFER_REDUNDANT
#define DEFER_REDUNDANT 1
#endif
#ifndef DEFER_FIRST
#define DEFER_FIRST 0
#endif
#ifndef DEFER_COLS
#define DEFER_COLS 0
#endif
struct DeferOrder { int idx; __device__ bool next(int i, pg8::Unit& u) const { if (i > 0 || idx < 0 || idx >= 96) return false; u.pm = idx & 31; u.pn = 48 + (idx >> 5); return true; }
    __device__ __forceinline__ void a_ready(const pg8::Unit&) const {} __device__ __forceinline__ void done(const pg8::Unit&) const {} };

__global__ void __launch_bounds__(NTHR) mega_fwd(Params p) {
    extern __shared__ __attribute__((aligned(16))) unsigned char lds_raw[];
    cg::grid_group grid = cg::this_grid();
    LAS unsigned char* lds = (LAS unsigned char*)lds_raw;
    const int G = gridDim.x, bx = blockIdx.x;
    const int vcu = (G % 8 == 0) ? (bx % 8) * (G / 8) + bx / 8 : bx;
    unsigned char* ws = p.ws;
    bf16_t* H = (bf16_t*)(ws + WS_H); bf16_t* PROJ = (bf16_t*)(ws + WS_PROJ); bf16_t* GATES = (bf16_t*)(ws + WS_GATES); bf16_t* Y = (bf16_t*)(ws + WS_Y);
    bf16_t* MERGED = (bf16_t*)(ws + WS_MERGED); float* OUTB = (float*)(ws + WS_OUT);
    const size_t SEC = (size_t)M * BW;

    unsigned* barw = (unsigned*)ws;
    { int t0 = threadIdx.x; if (bx == 0) for (int i = t0; i < XCD_BAR_WORDS; i += NTHR) barw[i] = 0u;
      if (t0 < 4) ((volatile LAS unsigned*)(lds + MISC_OFF))[t0] = 0u; }
    __syncthreads();
    prologue(p, lds, vcu, G);
    grid.sync();
    XcdBarrier xb = xcd_barrier_post(barw, (volatile LAS unsigned*)(lds + MISC_OFF));

    for (int l = 0; l < DEPTH; ++l) {
        const float lambda_init = 0.8f - 0.6f * __expf(-0.3f * (float)l);
#ifndef NO_G1
        for (int rep = 0; rep < ((REP_MASK & 4) ? 2 : 1); ++rep)
        { pg8::Gemm g{H, (const bf16_t*)(ws + WS_W1T + l * SZ_W1T), M, N1, DM}; pg8::StaticOrder S; S.init(M, N1 - (DEFER_REDUNDANT ? 0 : DEFER_COLS), G, bx);
          pg8::EpiG1 E{PROJ, GATES};
          pg8::gemm_phase<pg8::EpiG1, pg8::StaticOrder, true, true>(lds, g, S, E); }
#endif
        GSYNC();
        {
#if DEFER_FIRST
          if (DEFER_COLS) { pg8::Gemm g{H, (const bf16_t*)(ws + WS_W1T + l * SZ_W1T), M, N1, DM}; DeferOrder S{G >= 96 ? vcu - (G - 96) : vcu};
            pg8::EpiG1 E{PROJ, DEFER_REDUNDANT ? (bf16_t*)OUTB : GATES};
            pg8::gemm_phase<pg8::EpiG1, DeferOrder, true, true>(lds, g, S, E); }
#endif
#ifndef NO_ATTN
          for (int rep = 0; rep < ((REP_MASK & 1) ? 2 : 1); ++rep)
          for (int r = 0;; ++r) { const int u = r * G + ((r & 1) ? (G - 1 - vcu) : vcu); if (u >= 384) break;
              attn_unit(lds, u % 12, 31 - u / 12, PROJ + 2 * SEC, PROJ + 3 * SEC, PROJ + 4 * SEC, PROJ + 5 * SEC, p.rel_bias, p.lam + l * 256, p.subln_g + l * 128, lambda_init, Y + BW); }
#endif
#ifndef NO_POOL
          for (int rep = 0; rep < ((REP_MASK & 2) ? 2 : 1); ++rep)
          for (int u = vcu; u < 256; u += G)
              pool_unit(lds, u, PROJ, PROJ + SEC, (const bf16_t*)(ws + WS_WPT + l * SZ_WPT), p.pool_scale + l * BW, Y);
#endif
#ifndef NO_SGU
          for (int rep = 0; rep < ((REP_MASK & 2) ? 2 : 1); ++rep)
          for (int r = 0;; ++r) { const int u = r * G + ((r & 1) ? (G - 1 - vcu) : vcu); if (u >= 384) break;
              sgu_unit(lds, u, PROJ + 6 * SEC, PROJ + 7 * SEC, PROJ + 8 * SEC, p.sgu_ng + l * BW, p.sgu_nb + l * BW, p.sgu_w + (size_t)l * 6 * 128 * 128, p.sgu_b + l * 6 * 128, Y + 2 * BW); }
#endif
#if !DEFER_FIRST
          if (DEFER_COLS) { pg8::Gemm g{H, (const bf16_t*)(ws + WS_W1T + l * SZ_W1T), M, N1, DM}; DeferOrder S{G >= 96 ? vcu - (G - 96) : vcu};
            pg8::EpiG1 E{PROJ, DEFER_REDUNDANT ? (bf16_t*)OUTB : GATES};
            pg8::gemm_phase<pg8::EpiG1, DeferOrder, true, true>(lds, g, S, E); }
#endif
        }
        GSYNC();
#ifndef NO_G2
        for (int rep = 0; rep < ((REP_MASK & 8) ? 2 : 1); ++rep)
        { pg8::Gemm g{Y, (const bf16_t*)(ws + WS_WBT + l * SZ_WBT), M, DM, YW}; pg8::StaticOrder S; S.init(M, DM, G, bx);
          pg8::EpiG2h E{GATES, MERGED};
          pg8::gemm_phase<pg8::EpiG2h, pg8::StaticOrder, true, true>(lds, g, S, E); }
#endif
        GSYNC();
#ifndef NO_G3
        for (int rep = 0; rep < ((REP_MASK & 8) ? 2 : 1); ++rep)
        { pg8::Gemm g{MERGED, (const bf16_t*)(ws + WS_WOT + l * SZ_WOT), M, DM, DM}; pg8::StaticOrder S; S.init(M, DM, G, bx);
          pg8::EpiG3 E{OUTB};
          pg8::gemm_phase<pg8::EpiG3, pg8::StaticOrder, true, true>(lds, g, S, E); }
#endif
        GSYNC();
        rowpass(l == 0 ? p.x : p.out, p.out, OUTB, p.g_post + l * DM, (l + 1 < DEPTH) ? p.g_pre + (l + 1) * DM : nullptr, H, vcu, G);
        if (l + 1 < DEPTH) GSYNC();
    }
}

extern "C" void kernel_launch(void* const* d_in, const int* in_sizes, int n_in, void* d_out, int out_size, void* d_ws, size_t ws_size, hipStream_t stream) {
    static int grid = 0;
    if (grid == 0) {
        if (n_in != 16 || in_sizes[0] != M * DM || out_size != M * DM || ws_size < WS_END) { fprintf(stderr, "kernel_launch: unexpected shapes / workspace (%zu < %zu); nothing launched\n", ws_size, (size_t)WS_END); grid = -1; return; }
        int dev = 0, cus = 0, per_cu = 0;
        hipGetDevice(&dev); hipDeviceGetAttribute(&cus, hipDeviceAttributeMultiprocessorCount, dev);
        if (hipFuncSetAttribute((const void*)mega_fwd, hipFuncAttributeMaxDynamicSharedMemorySize, LDS_BYTES) != hipSuccess) { fprintf(stderr, "kernel_launch: hipFuncSetAttribute failed\n"); grid = -1; return; }
        if (hipOccupancyMaxActiveBlocksPerMultiprocessor(&per_cu, (const void*)mega_fwd, NTHR, LDS_BYTES) != hipSuccess || per_cu < 1) { fprintf(stderr, "kernel_launch: occupancy query failed (%d)\n", per_cu); (void)hipGetLastError(); per_cu = 1; }
        grid = cus * per_cu;
    }
    if (grid < 0) return;
    Params p{};
    p.x = (const float*)d_in[0]; p.rel_bias = (const float*)d_in[1]; p.g_pre = (const float*)d_in[2]; p.w_in = (const float*)d_in[3]; p.w_gate = (const float*)d_in[4];
    p.pool_w = (const float*)d_in[5]; p.pool_scale = (const float*)d_in[6]; p.lam = (const float*)d_in[7]; p.subln_g = (const float*)d_in[8]; p.sgu_ng = (const float*)d_in[9];
    p.sgu_nb = (const float*)d_in[10]; p.sgu_w = (const float*)d_in[11]; p.sgu_b = (const float*)d_in[12]; p.w_branch = (const float*)d_in[13]; p.w_out = (const float*)d_in[14]; p.g_post = (const float*)d_in[15];
    p.out = (float*)d_out; p.ws = (unsigned char*)d_ws;
    void* args[] = {&p};
    hipError_t e = hipLaunchCooperativeKernel((const void*)mega_fwd, dim3(grid), dim3(NTHR), args, LDS_BYTES, stream);
    if (e != hipSuccess) fprintf(stderr, "cooperative launch failed: %s (grid %d)\n", hipGetErrorString(e), grid);
}
```

```cpp
#include <hip/hip_runtime.h>
#include <hip/hip_cooperative_groups.h>
#include <cstdio>
#include <cstdint>
namespace cg = cooperative_groups;
#ifndef REP_MASK
#define REP_MASK 0
#endif
namespace pg8 {
#define PG8_LAS __attribute__((address_space(3)))
typedef unsigned short bf16_t;
typedef short bf16x8 __attribute__((ext_vector_type(8)));
typedef float f32x4 __attribute__((ext_vector_type(4)));
typedef unsigned u32x4 __attribute__((ext_vector_type(4)));
constexpr int BM = 256, BK = 64, HALF = 128, HTB = HALF * BK * 2  , STAGE_BYTES = 8 * HTB, NXCD = 8, WGM = 8;

__host__ __device__ __forceinline__ int lds_byte(int r, int c) { const int st = (r >> 4) * 2 + (c >> 5), rr = r & 15, cc = c & 31, ob = rr * 64 + cc * 2; return st * 1024 + (ob ^ (((ob >> 9) & 1) << 5)); }
__host__ __device__ __forceinline__ void stage_rc(int b, int& R, int& C) { const int st = b / 1024, sb = b % 1024, swz = sb ^ (((sb >> 9) & 1) << 5); R = (st >> 1) * 16 + swz / 64; C = (st & 1) * 32 + (swz % 64) / 2; }
__host__ __device__ __forceinline__ int perm32(int rho) { const int n = rho >> 4, i = rho & 15; return 8 * (i >> 2) + 4 * n + (i & 3); }

struct Unit { int pm, pn; };
struct Gemm { const bf16_t* A; const bf16_t* Bt; int M, N, K; };

struct StaticOrder {
    int nM, nN, nwg, G, c;
    __host__ __device__ void init(int M, int N, int G_, int c_) { nM = M / BM; nN = N / BM; nwg = nM * nN; G = G_; c = c_; }
    __host__ __device__ bool next(int i, Unit& u) const {
        const long L = (long)i * G + c; if (L >= nwg) return false;
        int wgid = (int)L; { const int q = nwg / NXCD, r = nwg % NXCD, xcd = wgid % NXCD, off = wgid / NXCD; wgid = (xcd < r ? xcd * (q + 1) : r * (q + 1) + (xcd - r) * q) + off; }
        const int nig = WGM * nN, gid = wgid / nig, fm = gid * WGM, gsz = (nM - fm) < WGM ? (nM - fm) : WGM;
        u.pm = fm + ((wgid % nig) % gsz); u.pn = (wgid % nig) / gsz; return true;
    }
    __device__ __forceinline__ void a_ready(const Unit&) const {}
    __device__ __forceinline__ void done(const Unit&) const {}
};

__device__ __forceinline__ unsigned cvt_pk_bf16(float lo, float hi) { unsigned r; asm volatile("v_cvt_pk_bf16_f32 %0, %1, %2" : "=v"(r) : "v"(lo), "v"(hi)); return r; }
typedef float f32x2 __attribute__((ext_vector_type(2)));
__device__ __forceinline__ f32x2 gelu_pk(f32x2 v) {
    const f32x2 av = __builtin_elementwise_abs(v), d = av * 0.2316418882f + 1.0f;
    f32x2 t; t.x = __builtin_amdgcn_rcpf(d.x); t.y = __builtin_amdgcn_rcpf(d.y);
    f32x2 q = t * 0.5307027145f + (-0.7265760135f); q = q * t + 0.7107068705f; q = q * t + (-0.142248368f); q = q * t + 0.127414796f; q = q * t;
    const f32x2 s = (v * v) * (-0.72134752044f);
    f32x2 e; e.x = __builtin_amdgcn_exp2f(s.x); e.y = __builtin_amdgcn_exp2f(s.y);
    const f32x2 m = v * (q * e), r = v - m;
    f32x2 o; o.x = v.x < 0.f ? m.x : r.x; o.y = v.y < 0.f ? m.y : r.y; return o;
}


__device__ __forceinline__ float bf_lo(unsigned u) { return __uint_as_float(u << 16); }
__device__ __forceinline__ float bf_hi(unsigned u) { return __uint_as_float(u & 0xffff0000u); }
__device__ __forceinline__ float act_sig(float x, float na, float nb, bool mulx) {
    const float z = x * (na + nb * x * x);
    const float s = __builtin_amdgcn_rcpf(1.0f + __builtin_amdgcn_exp2f(z));
    return mulx ? x * s : fmaxf(s, 1e-18f);
}
constexpr int TOK = 8192, BRW = 768, NGATE = 6144, DMODEL = 2048;
struct EpiG1 {
    static constexpr bool PERM = true, AFTER_DRAIN = false, MID = false;
    bf16_t* proj; bf16_t* gates;
    __device__ __forceinline__ void operator()(const f32x4 (&acc)[2][2][4][2], const Unit& u, int wr, int wc, int fr, int fq) const {
        const int row0 = u.pm * BM + wr * 64 + fr; const int pn = u.pn;
        bf16_t* base; int ldc, colt, act;
        if (pn < 27) { const int s = pn / 3; base = proj + (size_t)s * TOK * BRW; ldc = BRW; colt = (pn - 3 * s) * BM; act = (s == 1 || s == 5 || s == 8) ? 1 : ((s == 6 || s == 7) ? 2 : 0); }
        else { base = gates; ldc = NGATE; colt = (pn - 27) * BM; act = 3; }
        const int col0 = colt + wc * 32 + 8 * fq;
        if (act == 0) {
#pragma unroll
            for (int ai = 0; ai < 2; ++ai)
#pragma unroll
                for (int m = 0; m < 4; ++m) { bf16_t* rowp = base + (size_t)(row0 + ai * HALF + m * 16) * ldc + col0;
#pragma unroll
                    for (int bj = 0; bj < 2; ++bj) { const f32x4 v0 = acc[ai][bj][m][0], v1 = acc[ai][bj][m][1];
                        u32x4 w; w.x = cvt_pk_bf16(v0[0], v0[1]); w.y = cvt_pk_bf16(v0[2], v0[3]); w.z = cvt_pk_bf16(v1[0], v1[1]); w.w = cvt_pk_bf16(v1[2], v1[3]);
                        *(u32x4*)(rowp + bj * HALF) = w; } }
        } else {
            const float L2E = 1.4426950408889634f;
            const float na = (act == 2) ? -L2E * 1.5957691216057308f : -L2E, nb = (act == 2) ? -L2E * 1.5957691216057308f * 0.044715f : 0.f; const bool mulx = (act != 3);
#pragma unroll
            for (int ai = 0; ai < 2; ++ai)
#pragma unroll
                for (int m = 0; m < 4; ++m) { bf16_t* rowp = base + (size_t)(row0 + ai * HALF + m * 16) * ldc + col0;
#pragma unroll
                    for (int bj = 0; bj < 2; ++bj) { const f32x4 v0 = acc[ai][bj][m][0], v1 = acc[ai][bj][m][1];
                        u32x4 w; w.x = cvt_pk_bf16(act_sig(v0[0], na, nb, mulx), act_sig(v0[1], na, nb, mulx)); w.y = cvt_pk_bf16(act_sig(v0[2], na, nb, mulx), act_sig(v0[3], na, nb, mulx));
                        w.z = cvt_pk_bf16(act_sig(v1[0], na, nb, mulx), act_sig(v1[1], na, nb, mulx)); w.w = cvt_pk_bf16(act_sig(v1[2], na, nb, mulx), act_sig(v1[3], na, nb, mulx));
                        *(u32x4*)(rowp + bj * HALF) = w; } }
        }
    }
};
struct EpiG2 {
    static constexpr bool PERM = true, AFTER_DRAIN = false, MID = false;
    const bf16_t* gates; float* part; bf16_t* merged;
    __device__ __forceinline__ void operator()(const f32x4 (&acc)[2][2][4][2], const Unit& u, int wr, int wc, int fr, int fq) const {
        const int n = u.pm >> 5, pm = u.pm & 31, pn = u.pn & 7;
        const int row0 = pm * BM + wr * 64 + fr, col0 = pn * BM + wc * 32 + 8 * fq;
#pragma unroll
        for (int ai = 0; ai < 2; ++ai)
#pragma unroll
            for (int m = 0; m < 4; ++m) { const size_t r = (size_t)(row0 + ai * HALF + m * 16);
#pragma unroll
                for (int bj = 0; bj < 2; ++bj) { const int c = col0 + bj * HALF;
                    const u32x4 g = *(const u32x4*)(gates + r * NGATE + n * DMODEL + c);
                    f32x4 v0 = acc[ai][bj][m][0], v1 = acc[ai][bj][m][1];
                    v0[0] *= bf_lo(g.x); v0[1] *= bf_hi(g.x); v0[2] *= bf_lo(g.y); v0[3] *= bf_hi(g.y); v1[0] *= bf_lo(g.z); v1[1] *= bf_hi(g.z); v1[2] *= bf_lo(g.w); v1[3] *= bf_hi(g.w);
                    float* pp = part + r * DMODEL + c;
                    if (n == 0) { *(f32x4*)pp = v0; *(f32x4*)(pp + 4) = v1; }
                    else { v0 += *(const f32x4*)pp; v1 += *(const f32x4*)(pp + 4);
                        if (n == 1) { *(f32x4*)pp = v0; *(f32x4*)(pp + 4) = v1; }
                        else { u32x4 w; w.x = cvt_pk_bf16(v0[0], v0[1]); w.y = cvt_pk_bf16(v0[2], v0[3]); w.z = cvt_pk_bf16(v1[0], v1[1]); w.w = cvt_pk_bf16(v1[2], v1[3]); *(u32x4*)(merged + r * DMODEL + c) = w; } }
                } }
    }
};
struct G2Order {
    int G, c;
    __device__ bool next(int i, Unit& u) const { const int k = i / 3, n = i - 3 * k; const int pr = c + k * G; if (pr >= 256) return false; u.pm = n * 32 + (pr >> 3); u.pn = n * 8 + (pr & 7); return true; }
    __device__ __forceinline__ void a_ready(const Unit&) const {}
    __device__ __forceinline__ void done(const Unit&) const {}
};
struct EpiG3 {
    static constexpr bool PERM = true, AFTER_DRAIN = false, MID = false;
    float* out;
    __device__ __forceinline__ void operator()(const f32x4 (&acc)[2][2][4][2], const Unit& u, int wr, int wc, int fr, int fq) const {
        const int row0 = u.pm * BM + wr * 64 + fr, col0 = u.pn * BM + wc * 32 + 8 * fq;
#pragma unroll
        for (int ai = 0; ai < 2; ++ai)
#pragma unroll
            for (int m = 0; m < 4; ++m) { float* rowp = out + (size_t)(row0 + ai * HALF + m * 16) * DMODEL + col0;
#pragma unroll
                for (int bj = 0; bj < 2; ++bj) { *(f32x4*)(rowp + bj * HALF) = acc[ai][bj][m][0]; *(f32x4*)(rowp + bj * HALF + 4) = acc[ai][bj][m][1]; } }
    }
};

struct EpiG2h {
    static constexpr bool PERM = true, AFTER_DRAIN = false, MID = true;
    const bf16_t* gates; bf16_t* merged;
    __device__ __forceinline__ void mid(f32x4 (&acc)[2][2][4][2], const Unit& u, int s, int wr, int wc, int fr, int fq) const {
        int row0 = u.pm * BM + wr * 64 + fr; const int col0 = u.pn * BM + wc * 32 + 8 * fq;
        asm volatile("" : "+v"(row0));
#pragma unroll
        for (int ai = 0; ai < 2; ++ai)
#pragma unroll
            for (int m = 0; m < 4; ++m) { const bf16_t* gp = gates + (size_t)(row0 + ai * HALF + m * 16) * NGATE + (s - 1) * DMODEL + col0;
#pragma unroll
                for (int bj = 0; bj < 2; ++bj) { const u32x4 a = *(const u32x4*)(gp + bj * HALF), b = *(const u32x4*)(gp + DMODEL + bj * HALF);
                    f32x4 r0, r1;
                    r0[0] = bf_lo(a.x) * __builtin_amdgcn_rcpf(bf_lo(b.x)); r0[1] = bf_hi(a.x) * __builtin_amdgcn_rcpf(bf_hi(b.x)); r0[2] = bf_lo(a.y) * __builtin_amdgcn_rcpf(bf_lo(b.y)); r0[3] = bf_hi(a.y) * __builtin_amdgcn_rcpf(bf_hi(b.y));
                    r1[0] = bf_lo(a.z) * __builtin_amdgcn_rcpf(bf_lo(b.z)); r1[1] = bf_hi(a.z) * __builtin_amdgcn_rcpf(bf_hi(b.z)); r1[2] = bf_lo(a.w) * __builtin_amdgcn_rcpf(bf_lo(b.w)); r1[3] = bf_hi(a.w) * __builtin_amdgcn_rcpf(bf_hi(b.w));
                    acc[ai][bj][m][0] *= r0; acc[ai][bj][m][1] *= r1; asm volatile("" ::: "memory"); } }
    }
    __device__ __forceinline__ void operator()(const f32x4 (&acc)[2][2][4][2], const Unit& u, int wr, int wc, int fr, int fq) const {
        const int row0 = u.pm * BM + wr * 64 + fr, col0 = u.pn * BM + wc * 32 + 8 * fq;
#pragma unroll
        for (int ai = 0; ai < 2; ++ai)
#pragma unroll
            for (int m = 0; m < 4; ++m) { const size_t r = (size_t)(row0 + ai * HALF + m * 16);
#pragma unroll
                for (int bj = 0; bj < 2; ++bj) { const int c = col0 + bj * HALF;
                    const u32x4 g = *(const u32x4*)(gates + r * NGATE + 2 * DMODEL + c);
                    const f32x4 v0 = acc[ai][bj][m][0], v1 = acc[ai][bj][m][1];
                    u32x4 w; w.x = cvt_pk_bf16(v0[0] * bf_lo(g.x), v0[1] * bf_hi(g.x)); w.y = cvt_pk_bf16(v0[2] * bf_lo(g.y), v0[3] * bf_hi(g.y));
                    w.z = cvt_pk_bf16(v1[0] * bf_lo(g.z), v1[1] * bf_hi(g.z)); w.w = cvt_pk_bf16(v1[2] * bf_lo(g.w), v1[3] * bf_hi(g.w));
                    *(u32x4*)(merged + r * DMODEL + c) = w; } }
    }
};
template <class Epi, class Sched, bool ALIGN_EPI = false, bool SP2 = false>
__device__ __forceinline__ void gemm_phase(PG8_LAS unsigned char* lds, const Gemm g, const Sched& S, const Epi& E) {
    int tid_ = threadIdx.x; asm volatile("" : "+v"(tid_));
    const int tid = tid_, wid = __builtin_amdgcn_readfirstlane(tid >> 6), lane = tid & 63, wr = wid >> 2, wc = wid & 3, fr = lane & 15, fq = lane >> 4;
    const int K = g.K, nt = K / BK;
    unsigned voffA[2], voffB[2];
#pragma unroll
    for (int i = 0; i < 2; ++i) { int R, C; stage_rc(tid * 16 + i * 8192, R, C); const int Rb = Epi::PERM ? ((R & ~31) + perm32(R & 31)) : R;
        voffA[i] = (unsigned)(R * K + C) * 2u; voffB[i] = (unsigned)(Rb * K + C) * 2u; }
    const size_t kstep = (size_t)(BK * 2);
    const size_t hstep = (size_t)HALF * K * 2;
    const size_t tstep = 2 * hstep;
    const unsigned ldsw = (unsigned)wid * 1024u;
    const int aoff = lds_byte(wr * 64 + fr, fq * 8), boff = lds_byte(wc * 32 + fr, fq * 8);
#define PG8_SA(b, h) (((b) * 2 + (h)) * HTB)
#define PG8_SB(b, h) ((4 + (b) * 2 + (h)) * HTB)
#define PG8_STAGE(bufoff, gbase, voff) do { _Pragma("unroll") for (int _i = 0; _i < 2; ++_i) \
        __builtin_amdgcn_global_load_lds((const unsigned*)((const char*)(gbase) + (voff)[_i]), (PG8_LAS unsigned*)(lds + (bufoff) + ldsw + _i * 8192), 16, 0, 0); } while (0)
#define PG8_LDA(dst, b, h) do { _Pragma("unroll") for (int m = 0; m < 4; ++m) _Pragma("unroll") for (int k = 0; k < 2; ++k) dst[m][k] = *(const PG8_LAS bf16x8*)(lds + PG8_SA(b, h) + aoff + m * 2048 + k * 1024); } while (0)
#define PG8_LDB(dst, b, h) do { _Pragma("unroll") for (int n = 0; n < 2; ++n) _Pragma("unroll") for (int k = 0; k < 2; ++k) dst[n][k] = *(const PG8_LAS bf16x8*)(lds + PG8_SB(b, h) + boff + n * 2048 + k * 1024); } while (0)
#define PG8_MMA(ai, bj, At, Bt) do { __builtin_amdgcn_s_setprio(1); _Pragma("unroll") for (int m = 0; m < 4; ++m) _Pragma("unroll") for (int n = 0; n < 2; ++n) _Pragma("unroll") for (int k = 0; k < 2; ++k) \
        acc[ai][bj][m][n] = __builtin_amdgcn_mfma_f32_16x16x32_bf16(Bt[n][k], At[m][k], acc[ai][bj][m][n], 0, 0, 0); __builtin_amdgcn_s_setprio(0); } while (0)
#define PG8_WAIT_V(n) asm volatile("s_waitcnt vmcnt(" #n ")" ::: "memory")
#define PG8_WAIT_L(n) asm volatile("s_waitcnt lgkmcnt(" #n ")" ::: "memory")
#define PG8_BAR __builtin_amdgcn_s_barrier()
#define PG8_SCHED __builtin_amdgcn_sched_barrier(0)
    Unit cur, nxt; int ui = 0;
    if (!S.next(0, cur)) return;
    f32x4 acc[2][2][4][2];
#pragma unroll
    for (int a = 0; a < 2; ++a)
#pragma unroll
        for (int b = 0; b < 2; ++b)
#pragma unroll
            for (int m = 0; m < 4; ++m)
#pragma unroll
                for (int n = 0; n < 2; ++n) acc[a][b][m][n] = (f32x4){0.f, 0.f, 0.f, 0.f};
    bf16x8 At[4][2], B0[2][2], B1[2][2];
    const char* cA = (const char*)g.A + (size_t)cur.pm * tstep; const char* cB = (const char*)g.Bt + (size_t)cur.pn * tstep;
    S.a_ready(cur);
    if constexpr (SP2) {
        PG8_STAGE(PG8_SB(0, 0), cB, voffB); PG8_STAGE(PG8_SB(0, 1), cB + hstep, voffB); PG8_STAGE(PG8_SA(0, 0), cA, voffA); PG8_STAGE(PG8_SA(0, 1), cA + hstep, voffA);
        if (wr == 1) PG8_BAR;
        PG8_WAIT_V(2); PG8_BAR;
        PG8_STAGE(PG8_SB(1, 0), cB + kstep, voffB); PG8_STAGE(PG8_SA(1, 0), cA + kstep, voffA); PG8_STAGE(PG8_SB(1, 1), cB + hstep + kstep, voffB);
        PG8_WAIT_V(6); PG8_BAR;
    } else {
        PG8_STAGE(PG8_SB(0, 0), cB, voffB); PG8_STAGE(PG8_SA(0, 0), cA, voffA); PG8_STAGE(PG8_SB(0, 1), cB + hstep, voffB); PG8_STAGE(PG8_SA(0, 1), cA + hstep, voffA);
        if (wr == 1) PG8_BAR;
        PG8_WAIT_V(4); PG8_BAR;
        PG8_STAGE(PG8_SB(1, 0), cB + kstep, voffB); PG8_STAGE(PG8_SA(1, 0), cA + kstep, voffA); PG8_STAGE(PG8_SB(1, 1), cB + hstep + kstep, voffB);
        PG8_WAIT_V(6); PG8_BAR;
    }
    for (;;) {
        const bool has_next = S.next(ui + 1, nxt);
        const char* nA = has_next ? (const char*)g.A + (size_t)nxt.pm * tstep : cA; const char* nB = has_next ? (const char*)g.Bt + (size_t)nxt.pn * tstep : cB;
        for (int t = 0; t < nt; t += 2) {
            if constexpr (Epi::MID) { if (t == 12 || t == 24) E.mid(acc, cur, t / 12, wr, wc, fr, fq); }
            const bool last = (t == nt - 2);
            const char* a1 = cA + (size_t)(t + 1) * kstep;
            const char* a2 = last ? nA : cA + (size_t)(t + 2) * kstep; const char* b2 = last ? nB : cB + (size_t)(t + 2) * kstep;
            const char* a3 = a2 + kstep; const char* b3 = b2 + kstep;
            if (last && has_next) S.a_ready(nxt);
            if constexpr (SP2) {
            PG8_LDB(B0, 0, 0); PG8_LDB(B1, 0, 1); PG8_SCHED; PG8_LDA(At, 0, 0); PG8_STAGE(PG8_SA(1, 1), a1 + hstep, voffA);
            PG8_WAIT_V(8); PG8_WAIT_L(0); PG8_BAR; PG8_MMA(0, 0, At, B0); PG8_MMA(0, 1, At, B1); PG8_BAR; PG8_SCHED;
            PG8_LDA(At, 0, 1); PG8_STAGE(PG8_SB(0, 0), b2, voffB); PG8_STAGE(PG8_SB(0, 1), b2 + hstep, voffB); PG8_STAGE(PG8_SA(0, 0), a2, voffA);
            PG8_WAIT_V(8); PG8_WAIT_L(0); PG8_BAR; PG8_MMA(1, 0, At, B0); PG8_MMA(1, 1, At, B1); PG8_BAR; PG8_SCHED;
            PG8_LDB(B0, 1, 0); PG8_LDB(B1, 1, 1); PG8_SCHED; PG8_LDA(At, 1, 0); PG8_STAGE(PG8_SA(0, 1), a2 + hstep, voffA);
            PG8_WAIT_V(8); PG8_WAIT_L(0); PG8_BAR; PG8_MMA(0, 0, At, B0); PG8_MMA(0, 1, At, B1); PG8_BAR; PG8_SCHED;
            PG8_LDA(At, 1, 1); PG8_STAGE(PG8_SB(1, 0), b3, voffB); PG8_STAGE(PG8_SB(1, 1), b3 + hstep, voffB); PG8_STAGE(PG8_SA(1, 0), a3, voffA);
            PG8_WAIT_V(8); PG8_WAIT_L(0); PG8_BAR; PG8_MMA(1, 0, At, B0); PG8_MMA(1, 1, At, B1); PG8_BAR; PG8_SCHED;
            } else {
            PG8_LDB(B0, 0, 0); PG8_SCHED; PG8_LDA(At, 0, 0); PG8_STAGE(PG8_SA(1, 1), a1 + hstep, voffA);
            PG8_WAIT_L(8); PG8_BAR; PG8_WAIT_L(0); PG8_MMA(0, 0, At, B0); PG8_BAR; PG8_SCHED;
            PG8_LDB(B1, 0, 1); PG8_STAGE(PG8_SB(0, 0), b2, voffB);
            PG8_BAR; PG8_WAIT_L(0); PG8_MMA(0, 1, At, B1); PG8_BAR;
            PG8_LDA(At, 0, 1); PG8_STAGE(PG8_SA(0, 0), a2, voffA);
            PG8_BAR; PG8_WAIT_L(0); PG8_MMA(1, 0, At, B0); PG8_BAR; PG8_SCHED;
            PG8_STAGE(PG8_SB(0, 1), b2 + hstep, voffB);
            PG8_WAIT_V(6); PG8_BAR; PG8_MMA(1, 1, At, B1); PG8_BAR;
            PG8_LDB(B0, 1, 0); PG8_SCHED; PG8_LDA(At, 1, 0); PG8_STAGE(PG8_SA(0, 1), a2 + hstep, voffA);
            PG8_WAIT_L(8); PG8_BAR; PG8_WAIT_L(0); PG8_MMA(0, 0, At, B0); PG8_BAR; PG8_SCHED;
            PG8_LDB(B1, 1, 1); PG8_STAGE(PG8_SB(1, 0), b3, voffB);
            PG8_BAR; PG8_WAIT_L(0); PG8_MMA(0, 1, At, B1); PG8_BAR;
            PG8_LDA(At, 1, 1); PG8_STAGE(PG8_SA(1, 0), a3, voffA);
            PG8_BAR; PG8_WAIT_L(0); PG8_MMA(1, 0, At, B0); PG8_BAR; PG8_SCHED;
            PG8_STAGE(PG8_SB(1, 1), b3 + hstep, voffB);
            PG8_WAIT_V(6); PG8_BAR; PG8_MMA(1, 1, At, B1); PG8_BAR;
            }
        }
        if constexpr (ALIGN_EPI) { if (wr == 0) PG8_BAR; }
        if constexpr (!Epi::AFTER_DRAIN) { E(acc, cur, wr, wc, fr, fq); S.done(cur); }
        if (!has_next) break;
#pragma unroll
        for (int a = 0; a < 2; ++a)
#pragma unroll
            for (int b = 0; b < 2; ++b)
#pragma unroll
                for (int m = 0; m < 4; ++m)
#pragma unroll
                    for (int n = 0; n < 2; ++n) acc[a][b][m][n] = (f32x4){0.f, 0.f, 0.f, 0.f};
        cur = nxt; cA = nA; cB = nB; ++ui;
        if constexpr (ALIGN_EPI) { if (wr == 1) PG8_BAR; }
    }
    PG8_WAIT_V(0);
    if constexpr (!ALIGN_EPI) { if (wr == 0) PG8_BAR; }
    PG8_BAR;
    if constexpr (Epi::AFTER_DRAIN) { E.fused(acc, cur, wr, wc, fr, fq, lds, wid, lane); S.done(cur); }
#undef PG8_SA
#undef PG8_SB
#undef PG8_STAGE
#undef PG8_LDA
#undef PG8_LDB
#undef PG8_MMA
#undef PG8_WAIT_V
#undef PG8_WAIT_L
#undef PG8_BAR
#undef PG8_SCHED
}
}

#ifndef PG8_SP2
#define PG8_SP2 true
#endif
#ifndef PG8_ALIGN
#define PG8_ALIGN true
#endif

#define LAS __attribute__((address_space(3)))
typedef unsigned short bf16_t;
typedef short bf16x8 __attribute__((ext_vector_type(8)));
typedef short s16x4 __attribute__((ext_vector_type(4)));
typedef float f32x4 __attribute__((ext_vector_type(4)));
typedef float f32x2 __attribute__((ext_vector_type(2)));
typedef unsigned u32x4 __attribute__((ext_vector_type(4)));
typedef unsigned u32x2 __attribute__((ext_vector_type(2)));
using pg8::cvt_pk_bf16; using pg8::bf_lo; using pg8::bf_hi;

constexpr int NB = 2, SEQ = 4096, DM = 2048, DEPTH = 4, M = NB * SEQ, BW = 768, DIN = 6912, NGT = 6144, N1 = DIN + NGT;
constexpr int NH = 6, YW = 3 * BW;
constexpr float EPS = 1e-6f, L2E = 1.4426950408889634f;
constexpr int NWAVES = 8, NTHR = 512;
constexpr int LDS_BYTES = 147456;

constexpr size_t SZ_W1T = (size_t)N1 * DM * 2, SZ_WBT = (size_t)3 * DM * BW * 2, SZ_WOT = (size_t)DM * DM * 2, SZ_WPT = (size_t)4 * 192 * 192 * 2;
constexpr size_t WS_W1T = 1u << 20;
constexpr size_t WS_WBT = WS_W1T + DEPTH * SZ_W1T;
constexpr size_t WS_WOT = WS_WBT + DEPTH * SZ_WBT;
constexpr size_t WS_WPT = WS_WOT + DEPTH * SZ_WOT;
constexpr size_t WS_H = (WS_WPT + DEPTH * SZ_WPT + 4095) & ~(size_t)4095;
constexpr size_t WS_PROJ = WS_H + (size_t)M * DM * 2;
constexpr size_t WS_GATES = WS_PROJ + (size_t)9 * M * BW * 2;
constexpr size_t WS_Y = WS_GATES + (size_t)M * NGT * 2;
constexpr size_t WS_MERGED = WS_Y + (size_t)3 * M * BW * 2;
constexpr size_t WS_OUT = WS_MERGED + (size_t)M * DM * 2;
constexpr size_t WS_END = WS_OUT + (size_t)M * DM * 4;

struct Params {
    const float *x, *rel_bias, *g_pre, *w_in, *w_gate, *pool_w, *pool_scale, *lam, *subln_g, *sgu_ng, *sgu_nb, *sgu_w, *sgu_b, *w_branch, *w_out, *g_post;
    float* out; unsigned char* ws;
};

__device__ __forceinline__ float wave_sum(float v) {
#pragma unroll
    for (int o = 1; o < 64; o <<= 1) v += __shfl_xor(v, o);
    return v;
}
__device__ __forceinline__ float dot4(f32x4 a) { return (a.x * a.x + a.y * a.y) + (a.z * a.z + a.w * a.w); }

__device__ __forceinline__ void transpose_item(const float* W, int K, int N, bf16_t* WT, int row_off, LAS float* scr, int item, int lane) {
    const int nblk = N / 32, kb = item / nblk, nb = item % nblk, k0 = 64 * kb, n0 = 32 * nb;
#pragma unroll 8
    for (int i = 0; i < 32; ++i) { const int kk = 2 * i + (lane >> 5); scr[kk * 33 + (lane & 31)] = W[(size_t)(k0 + kk) * N + n0 + (lane & 31)]; }
    asm volatile("s_waitcnt lgkmcnt(0)" ::: "memory");
    const int c = lane & 7;
#pragma unroll
    for (int j = 0; j < 4; ++j) { const int n = (lane >> 3) + 8 * j; const LAS float* s = scr + (8 * c) * 33 + n;
        u32x4 o; o.x = cvt_pk_bf16(s[0 * 33], s[1 * 33]); o.y = cvt_pk_bf16(s[2 * 33], s[3 * 33]); o.z = cvt_pk_bf16(s[4 * 33], s[5 * 33]); o.w = cvt_pk_bf16(s[6 * 33], s[7 * 33]);
        *(u32x4*)(WT + (size_t)(row_off + n0 + n) * K + k0 + 8 * c) = o; }
    asm volatile("s_waitcnt lgkmcnt(0)" ::: "memory");
}

__device__ __forceinline__ void rms_row_to_bf16(const float* xrow, const float* g, bf16_t* orow, int lane) {
    const f32x4* xr = (const f32x4*)xrow + lane; const f32x4* gr = (const f32x4*)g + lane;
    f32x4 v[8]; float s = 0.f;
#pragma unroll
    for (int j = 0; j < 8; ++j) { v[j] = xr[64 * j]; s += dot4(v[j]); }
    const float rstd = 1.0f / sqrtf(wave_sum(s) * (1.f / DM) + EPS);
    u32x2* o8 = (u32x2*)orow + lane;
#pragma unroll
    for (int j = 0; j < 8; ++j) { const f32x4 gg = gr[64 * j]; u32x2 w; w.x = cvt_pk_bf16(v[j].x * rstd * gg.x, v[j].y * rstd * gg.y); w.y = cvt_pk_bf16(v[j].z * rstd * gg.z, v[j].w * rstd * gg.w); o8[64 * j] = w; }
}

constexpr int I_IN = 32 * 216, I_G = 32 * 192, I_B1 = 12 * 64, I_B = 3 * I_B1, I_O = 32 * 64, I_P1 = 18, I_P = 4 * I_P1, I_LAYER = I_IN + I_G + I_B + I_O + I_P;

__device__ __forceinline__ void prologue(const Params& p, LAS unsigned char* lds, int vcu, int G) {
    int tid = threadIdx.x; asm volatile("" : "+v"(tid)); const int lane = tid & 63, wave = __builtin_amdgcn_readfirstlane(tid >> 6); const int gw = vcu * NWAVES + wave, NGW = G * NWAVES;
    LAS float* scr = (LAS float*)(lds + wave * 16384);
    unsigned char* ws = p.ws;
    for (int it = gw; it < DEPTH * I_LAYER; it += NGW) {
        const int l = it / I_LAYER; int r = it - l * I_LAYER;
        bf16_t* w1t = (bf16_t*)(ws + WS_W1T + l * SZ_W1T);
        if (r < I_IN) { transpose_item(p.w_in + (size_t)l * DM * DIN, DM, DIN, w1t, 0, scr, r, lane); continue; } r -= I_IN;
        if (r < I_G) { transpose_item(p.w_gate + (size_t)l * DM * NGT, DM, NGT, w1t, DIN, scr, r, lane); continue; } r -= I_G;
        if (r < I_B) { transpose_item(p.w_branch + (size_t)l * YW * DM, YW, DM, (bf16_t*)(ws + WS_WBT + l * SZ_WBT), 0, scr, r, lane); continue; } r -= I_B;
        if (r < I_O) { transpose_item(p.w_out + (size_t)l * DM * DM, DM, DM, (bf16_t*)(ws + WS_WOT + l * SZ_WOT), 0, scr, r, lane); continue; } r -= I_O;
        { const int g = r / I_P1, rr = r - g * I_P1; transpose_item(p.pool_w + (size_t)(l * 4 + g) * 192 * 192, 192, 192, (bf16_t*)(ws + WS_WPT + l * SZ_WPT) + g * 192 * 192, 0, scr, rr, lane); }
    }
    for (int m = gw; m < M; m += NGW) rms_row_to_bf16(p.x + (size_t)m * DM, p.g_pre, (bf16_t*)(ws + WS_H) + (size_t)m * DM, lane);
}

__device__ __forceinline__ void rowpass(const float* xin, float* xout, const float* outb, const float* gpost, const float* gnext, bf16_t* H, int vcu, int G) {
    int tid = threadIdx.x; asm volatile("" : "+v"(tid)); const int lane = tid & 63, wave = __builtin_amdgcn_readfirstlane(tid >> 6); const int gw = vcu * NWAVES + wave, NGW = G * NWAVES;
    for (int m = gw; m < M; m += NGW) {
        const f32x4* o4 = (const f32x4*)(outb + (size_t)m * DM) + lane; const f32x4* x4 = (const f32x4*)(xin + (size_t)m * DM) + lane;
        f32x4* xo = (f32x4*)(xout + (size_t)m * DM) + lane; const f32x4* gp = (const f32x4*)gpost + lane;
        f32x4 o[8]; float ss = 0.f;
#pragma unroll
        for (int j = 0; j < 8; ++j) { o[j] = o4[64 * j]; ss += dot4(o[j]); }
        const float rstd = 1.0f / sqrtf(wave_sum(ss) * (1.f / DM) + EPS);
        float s2 = 0.f;
#pragma unroll
        for (int j = 0; j < 8; ++j) { const f32x4 g = gp[64 * j]; const f32x4 xv = x4[64 * j]; o[j] = xv + o[j] * rstd * g; s2 += dot4(o[j]); xo[64 * j] = o[j]; }
        if (gnext) {
            const float r2 = 1.0f / sqrtf(wave_sum(s2) * (1.f / DM) + EPS);
            const f32x4* gn = (const f32x4*)gnext + lane; u32x2* h8 = (u32x2*)(H + (size_t)m * DM) + lane;
#pragma unroll
            for (int j = 0; j < 8; ++j) { const f32x4 g = gn[64 * j]; u32x2 w; w.x = cvt_pk_bf16(o[j].x * r2 * g.x, o[j].y * r2 * g.y); w.y = cvt_pk_bf16(o[j].z * r2 * g.z, o[j].w * r2 * g.w); h8[64 * j] = w; }
        }
    }
}

__device__ __forceinline__ bf16x8 mk8(u32x4 v) { return __builtin_bit_cast(bf16x8, v); }
#define MFMA16(a, b, c) __builtin_amdgcn_mfma_f32_16x16x32_bf16((a), (b), (c), 0, 0, 0)

__device__ __forceinline__ void pool_unit(LAS unsigned char* lds, int u, const bf16_t* ax, const bf16_t* ag, const bf16_t* wpt, const float* pscale, bf16_t* y0) {
    int tid = threadIdx.x; asm volatile("" : "+v"(tid)); const int lane = tid & 63, wave = __builtin_amdgcn_readfirstlane(tid >> 6);
    const int tt = u >> 2, g = u & 3, wl = 2 << g, t0 = tt * 128;
    constexpr int POOL_RAW = 51200;
    { const bool head = ((t0 & (SEQ - 1)) == 0);
      u32x4 v[7];
#pragma unroll
      for (int i = 0; i < 7; ++i) { const int it = tid + i * NTHR, rr = it / 24, ch = it - rr * 24;
          v[i] = (u32x4){0u, 0u, 0u, 0u};
          if (it < 143 * 24 && !(head && rr < 15)) v[i] = *(const u32x4*)(ax + (size_t)(t0 - 15 + rr) * BW + g * 192 + ch * 8); }
#pragma unroll
      for (int i = 0; i < 7; ++i) { const int it = tid + i * NTHR, rr = it / 24, ch = it - rr * 24;
          if (it < 143 * 24) *(LAS u32x4*)(lds + POOL_RAW + rr * 400 + ch * 16) = v[i]; }
    }
    __syncthreads();
#pragma unroll 2
    for (int i6 = 0; i6 < 6; ++i6) { const int it = tid + i6 * NTHR;
        const int r = it / 24, ch = it - r * 24; const int ts = (t0 + r) & (SEQ - 1);
        const int cnt = (ts + 1 < wl) ? ts + 1 : wl;
        const LAS unsigned char* src = lds + POOL_RAW + (r + 15) * 400 + ch * 16;
        const u32x4 cur = *(const LAS u32x4*)src;
        const f32x4 xa = {bf_lo(cur.x), bf_hi(cur.x), bf_lo(cur.y), bf_hi(cur.y)}, xb = {bf_lo(cur.z), bf_hi(cur.z), bf_lo(cur.w), bf_hi(cur.w)};
        f32x4 sa = xa, sb = xb;
        for (int k = 1; k < cnt; ++k) { const u32x4 v = *(const LAS u32x4*)(src - k * 400);
            sa += (f32x4){bf_lo(v.x), bf_hi(v.x), bf_lo(v.y), bf_hi(v.y)}; sb += (f32x4){bf_lo(v.z), bf_hi(v.z), bf_lo(v.w), bf_hi(v.w)}; }
        const float ic = 1.0f / (float)cnt;
        sa = sa * ic - xa; sb = sb * ic - xb;
        u32x4 w; w.x = cvt_pk_bf16(sa.x, sa.y); w.y = cvt_pk_bf16(sa.z, sa.w); w.z = cvt_pk_bf16(sb.x, sb.y); w.w = cvt_pk_bf16(sb.z, sb.w);
        *(LAS u32x4*)(lds + r * 400 + ch * 16) = w;
    }
    __syncthreads();
    const int fr = lane & 15, fq = lane >> 4;
    for (int dt = wave; dt < 12; dt += 8) {
        const bf16_t* wbase = wpt + g * 192 * 192 + (16 * dt + fr) * 192 + fq * 8;
        bf16x8 wf[6];
#pragma unroll
        for (int ks = 0; ks < 6; ++ks) wf[ks] = *(const bf16x8*)(wbase + ks * 32);
        const int col = g * 192 + 16 * dt + 4 * fq;
        const f32x4 sc = *(const f32x4*)(pscale + col);
#pragma unroll 2
        for (int tt = 0; tt < 8; ++tt) {
            const int t = t0 + 16 * tt + fr;
            const u32x2 gg = *(const u32x2*)(ag + (size_t)t * BW + col);
            const LAS unsigned char* prow = lds + (16 * tt + fr) * 400 + fq * 16;
            f32x4 acc = {0.f, 0.f, 0.f, 0.f};
#pragma unroll
            for (int ks = 0; ks < 6; ++ks) { const bf16x8 pf = *(const LAS bf16x8*)(prow + ks * 64); acc = MFMA16(wf[ks], pf, acc); }
            const f32x4 v = acc * sc * (f32x4){bf_lo(gg.x), bf_hi(gg.x), bf_lo(gg.y), bf_hi(gg.y)};
            u32x2 w; w.x = cvt_pk_bf16(v.x, v.y); w.y = cvt_pk_bf16(v.z, v.w); *(u32x2*)(y0 + (size_t)t * YW + col) = w;
        }
    }
    __syncthreads();
}

typedef short v4i16s_t __attribute__((ext_vector_type(4)));
__device__ __forceinline__ s16x4 vtr_s(const LAS unsigned char* p) { return __builtin_bit_cast(s16x4, __builtin_amdgcn_ds_read_tr16_b64_v4i16((LAS v4i16s_t*)p)); }
__device__ __forceinline__ void sgu_unit(LAS unsigned char* lds, int u, const bf16_t* cu, const bf16_t* cv, const bf16_t* cgt, const float* ng, const float* nb, const float* wsf, const float* bs, bf16_t* y2) {
    int tid = threadIdx.x; asm volatile("" : "+v"(tid)); const int lane = tid & 63, wave = __builtin_amdgcn_readfirstlane(tid >> 6);
    const int ci = u / 6, g = u - 6 * ci, t0 = ci * 128;
    const int fr = lane & 15, fq = lane >> 4;
    LAS f32x2* stats = (LAS f32x2*)(lds + 36864);
#pragma unroll
    for (int i = 0; i < 4; ++i) { const int row = 16 * wave + 4 * i + fq; const u32x4* src = (const u32x4*)(cv + (size_t)(t0 + row) * BW) + fr;
        u32x4 v[6];
#pragma unroll
        for (int c = 0; c < 6; ++c) v[c] = src[16 * c];
        float s = 0.f, s2 = 0.f;
#pragma unroll
        for (int c = 0; c < 6; ++c) { const float a0 = bf_lo(v[c].x), a1 = bf_hi(v[c].x), a2 = bf_lo(v[c].y), a3 = bf_hi(v[c].y), a4 = bf_lo(v[c].z), a5 = bf_hi(v[c].z), a6 = bf_lo(v[c].w), a7 = bf_hi(v[c].w);
            s += ((a0 + a1) + (a2 + a3)) + ((a4 + a5) + (a6 + a7)); s2 += ((a0 * a0 + a1 * a1) + (a2 * a2 + a3 * a3)) + ((a4 * a4 + a5 * a5) + (a6 * a6 + a7 * a7)); }
#pragma unroll
        for (int o = 1; o < 16; o <<= 1) { s += __shfl_xor(s, o); s2 += __shfl_xor(s2, o); }
        const float mean = s * (1.f / BW); float var = s2 * (1.f / BW) - mean * mean; var = var > 0.f ? var : 0.f;
        if (fr == 0) stats[row] = (f32x2){mean, 1.0f / sqrtf(var + EPS)};
    }
    __syncthreads();
#pragma unroll
    for (int it = 0; it < 4; ++it) { const int item = tid + NTHR * it, chn = item & 15, q = item >> 4;
        const f32x2 st = stats[q]; const u32x4 v = *(const u32x4*)(cv + (size_t)(t0 + q) * BW + g * 128 + chn * 8);
        const f32x4 ga = *(const f32x4*)(ng + g * 128 + chn * 8), gb = *(const f32x4*)(ng + g * 128 + chn * 8 + 4), ba = *(const f32x4*)(nb + g * 128 + chn * 8), bb = *(const f32x4*)(nb + g * 128 + chn * 8 + 4);
        f32x4 xa = {bf_lo(v.x), bf_hi(v.x), bf_lo(v.y), bf_hi(v.y)}, xb = {bf_lo(v.z), bf_hi(v.z), bf_lo(v.w), bf_hi(v.w)};
        xa = (xa - st.x) * st.y * ga + ba; xb = (xb - st.x) * st.y * gb + bb;
        u32x4 w; w.x = cvt_pk_bf16(xa.x, xa.y); w.y = cvt_pk_bf16(xa.z, xa.w); w.z = cvt_pk_bf16(xb.x, xb.y); w.w = cvt_pk_bf16(xb.z, xb.w);
        *(LAS u32x4*)(lds + q * 288 + chn * 16) = w;
    }
    __syncthreads();
    const int pp = 16 * wave + fr;
    f32x4 acc[8];
#pragma unroll
    for (int c = 0; c < 8; ++c) acc[c] = (f32x4){0.f, 0.f, 0.f, 0.f};
    f32x4 wa[4], wb[4];
#pragma unroll
    for (int ks = 0; ks < 4; ++ks) { const float* wp = wsf + (size_t)(g * 128 + pp) * 128 + 32 * ks + 4 * fq; wa[ks] = *(const f32x4*)wp; wb[ks] = *(const f32x4*)(wp + 16); }
    u32x2 uu[8], gg8[8];
#pragma unroll
    for (int c = 0; c < 8; ++c) { const int col = g * 128 + 16 * c + 4 * fq; uu[c] = *(const u32x2*)(cu + (size_t)(t0 + pp) * BW + col); gg8[c] = *(const u32x2*)(cgt + (size_t)(t0 + pp) * BW + col); }
    const LAS unsigned char* Vb = lds + (4 * fq + ((lane & 15) >> 2)) * 288 + (lane & 3) * 8;
#pragma unroll
    for (int ks = 0; ks < 4; ++ks) {
        if (32 * ks <= 16 * wave + 15) {
            const int q0 = 32 * ks + 4 * fq;
            f32x4 a = wa[ks], b = wb[ks];
            a.x = (q0 + 0 <= pp) ? a.x : 0.f; a.y = (q0 + 1 <= pp) ? a.y : 0.f; a.z = (q0 + 2 <= pp) ? a.z : 0.f; a.w = (q0 + 3 <= pp) ? a.w : 0.f;
            b.x = (q0 + 16 <= pp) ? b.x : 0.f; b.y = (q0 + 17 <= pp) ? b.y : 0.f; b.z = (q0 + 18 <= pp) ? b.z : 0.f; b.w = (q0 + 19 <= pp) ? b.w : 0.f;
            u32x4 wv; wv.x = cvt_pk_bf16(a.x, a.y); wv.y = cvt_pk_bf16(a.z, a.w); wv.z = cvt_pk_bf16(b.x, b.y); wv.w = cvt_pk_bf16(b.z, b.w);
            const bf16x8 wf = mk8(wv);
#pragma unroll
            for (int c = 0; c < 8; ++c) { const s16x4 lo = vtr_s(Vb + (32 * ks) * 288 + c * 32), hi = vtr_s(Vb + (32 * ks + 16) * 288 + c * 32);
                const bf16x8 vf = (bf16x8){lo[0], lo[1], lo[2], lo[3], hi[0], hi[1], hi[2], hi[3]};
                acc[c] = MFMA16(vf, wf, acc[c]); }
        }
    }
    const int t = t0 + pp; const float bias = bs[g * 128 + pp];
#pragma unroll
    for (int c = 0; c < 8; ++c) { const int col = g * 128 + 16 * c + 4 * fq;
        const f32x4 v = (acc[c] + bias) * (f32x4){bf_lo(uu[c].x), bf_hi(uu[c].x), bf_lo(uu[c].y), bf_hi(uu[c].y)} * (f32x4){bf_lo(gg8[c].x), bf_hi(gg8[c].x), bf_lo(gg8[c].y), bf_hi(gg8[c].y)};
        u32x2 w; w.x = cvt_pk_bf16(v.x, v.y); w.y = cvt_pk_bf16(v.z, v.w); *(u32x2*)(y2 + (size_t)t * YW + col) = w; }
    __syncthreads();
}

constexpr int AK_STRIDE = 272, AV_STRIDE = 288, AK_BYTES = 64 * AK_STRIDE, AV_BYTES = 64 * AV_STRIDE, AV_OFF = 2 * AK_BYTES, ATBL_OFF = AV_OFF + 2 * AV_BYTES;
typedef short v4i16_t __attribute__((ext_vector_type(4)));
__device__ __forceinline__ s16x4 vtr(const LAS unsigned char* p) { return __builtin_bit_cast(s16x4, __builtin_amdgcn_ds_read_tr16_b64_v4i16((LAS v4i16_t*)p)); }

__device__ __forceinline__ float xmax16(float v) { auto r = __builtin_amdgcn_permlane16_swap(__float_as_uint(v), __float_as_uint(v), false, false); return fmaxf(__uint_as_float(r[0]), __uint_as_float(r[1])); }
__device__ __forceinline__ float xmax32(float v) { auto r = __builtin_amdgcn_permlane32_swap(__float_as_uint(v), __float_as_uint(v), false, false); return fmaxf(__uint_as_float(r[0]), __uint_as_float(r[1])); }
__device__ __forceinline__ void attn_unit(LAS unsigned char* lds, int bh, int qb, const bf16_t* Qs, const bf16_t* Ks, const bf16_t* Vs, const bf16_t* bg, const float* rel_bias, const float* lam, const float* subg, float lambda_init, bf16_t* y1) {
    int tid = threadIdx.x; asm volatile("" : "+v"(tid)); const int lane = tid & 63, wave = __builtin_amdgcn_readfirstlane(tid >> 6);
    const int b = bh / NH, h = bh - NH * b;
    const int fr = lane & 15, fq = lane >> 4;
    const int nt = 2 * qb + 2, jmax = 2 * qb + (wave >> 2), jnear = 2 * qb - 2;
    LAS float* tbl = (LAS float*)(lds + ATBL_OFF);
    { const int rel = tid - 256, n = rel < 0 ? -rel : rel;
      const int large = 8 + (n >= 12) + (n >= 16) + (n >= 23) + (n >= 32) + (n >= 46) + (n >= 64) + (n >= 91);
      const int bucket = (rel > 0 ? 16 : 0) + (n < 8 ? n : large);
      tbl[tid] = rel_bias[bucket * NH + h] * L2E; }
    const float c15 = rel_bias[15 * NH + h] * L2E;
    float lam_full;
    { const float a = lam[lane] * lam[64 + lane], c = lam[128 + lane] * lam[192 + lane]; lam_full = __expf(wave_sum(a)) - __expf(wave_sum(c)) + lambda_init; }
    const size_t rowbase = (size_t)b * SEQ;
    const int qpos = 128 * qb + 16 * wave + fr;
    bf16x8 qf[2][2];
    { const bf16_t* qp = Qs + (rowbase + qpos) * BW + h * 128 + fq * 8;
#pragma unroll
      for (int br = 0; br < 2; ++br)
#pragma unroll
          for (int ks = 0; ks < 2; ++ks) qf[br][ks] = *(const bf16x8*)(qp + br * 64 + ks * 32); }
    const int srow = tid >> 4, sch = tid & 15;
    const bf16_t* kg = Ks + (rowbase + srow) * BW + h * 128 + sch * 8;
    const bf16_t* vg = Vs + (rowbase + srow) * BW + h * 128 + sch * 8;
    u32x4 sk0, sk1, sv0, sv1;
    sk0 = *(const u32x4*)kg; sk1 = *(const u32x4*)(kg + 32 * BW); sv0 = *(const u32x4*)vg; sv1 = *(const u32x4*)(vg + 32 * BW);
    *(LAS u32x4*)(lds + srow * AK_STRIDE + sch * 16) = sk0; *(LAS u32x4*)(lds + (srow + 32) * AK_STRIDE + sch * 16) = sk1;
    *(LAS u32x4*)(lds + AV_OFF + srow * AV_STRIDE + sch * 16) = sv0; *(LAS u32x4*)(lds + AV_OFF + (srow + 32) * AV_STRIDE + sch * 16) = sv1;
    __syncthreads();
    f32x4 o1[8], o2[8];
#pragma unroll
    for (int d = 0; d < 8; ++d) { o1[d] = (f32x4){0.f, 0.f, 0.f, 0.f}; o2[d] = (f32x4){0.f, 0.f, 0.f, 0.f}; }
    float m1 = -1e30f, m2 = -1e30f, l1 = 0.f, l2 = 0.f;
    const float CS = 0.125f * L2E;
    const int kvoff = fr * AK_STRIDE + fq * 16;
    const int vvoff = (4 * fq + ((lane & 15) >> 2)) * AV_STRIDE + (lane & 3) * 8;
    for (int j = 0; j < nt; ++j) {
        const bool more = (j + 1 < nt);
        if (more) { const size_t adv = (size_t)(j + 1) * 64 * BW;
            sk0 = *(const u32x4*)(kg + adv); sk1 = *(const u32x4*)(kg + adv + 32 * BW); sv0 = *(const u32x4*)(vg + adv); sv1 = *(const u32x4*)(vg + adv + 32 * BW); }
        if (j <= jmax) {
            const LAS unsigned char* Kb = lds + (j & 1) * AK_BYTES + kvoff;
            const LAS unsigned char* Vb = lds + AV_OFF + (j & 1) * AV_BYTES + vvoff;
            f32x4 s1[4], s2[4];
#pragma unroll
            for (int kt = 0; kt < 4; ++kt) {
                const bf16x8 k00 = *(const LAS bf16x8*)(Kb + kt * 16 * AK_STRIDE), k01 = *(const LAS bf16x8*)(Kb + kt * 16 * AK_STRIDE + 64);
                const bf16x8 k10 = *(const LAS bf16x8*)(Kb + kt * 16 * AK_STRIDE + 128), k11 = *(const LAS bf16x8*)(Kb + kt * 16 * AK_STRIDE + 192);
                f32x4 z = {0.f, 0.f, 0.f, 0.f};
                s1[kt] = MFMA16(k00, qf[0][0], z); s1[kt] = MFMA16(k01, qf[0][1], s1[kt]);
                s2[kt] = MFMA16(k10, qf[1][0], z); s2[kt] = MFMA16(k11, qf[1][1], s2[kt]);
            }
            const bool near = (j >= jnear);
            if (near) {
                const int ib = 64 * j + 4 * fq - qpos + 256;
#pragma unroll
                for (int kt = 0; kt < 4; ++kt) {
                    const float b0 = tbl[ib + 16 * kt], b1 = tbl[ib + 16 * kt + 1], b2 = tbl[ib + 16 * kt + 2], b3 = tbl[ib + 16 * kt + 3];
                    s1[kt].x = s1[kt].x * CS + b0; s1[kt].y = s1[kt].y * CS + b1; s1[kt].z = s1[kt].z * CS + b2; s1[kt].w = s1[kt].w * CS + b3;
                    s2[kt].x = s2[kt].x * CS + b0; s2[kt].y = s2[kt].y * CS + b1; s2[kt].z = s2[kt].z * CS + b2; s2[kt].w = s2[kt].w * CS + b3;
                }
            }
            float x1 = fmaxf(fmaxf(fmaxf(s1[0].x, s1[0].y), fmaxf(s1[0].z, s1[0].w)), fmaxf(fmaxf(s1[1].x, s1[1].y), fmaxf(s1[1].z, s1[1].w)));
            x1 = fmaxf(x1, fmaxf(fmaxf(fmaxf(s1[2].x, s1[2].y), fmaxf(s1[2].z, s1[2].w)), fmaxf(fmaxf(s1[3].x, s1[3].y), fmaxf(s1[3].z, s1[3].w))));
            float x2 = fmaxf(fmaxf(fmaxf(s2[0].x, s2[0].y), fmaxf(s2[0].z, s2[0].w)), fmaxf(fmaxf(s2[1].x, s2[1].y), fmaxf(s2[1].z, s2[1].w)));
            x2 = fmaxf(x2, fmaxf(fmaxf(fmaxf(s2[2].x, s2[2].y), fmaxf(s2[2].z, s2[2].w)), fmaxf(fmaxf(s2[3].x, s2[3].y), fmaxf(s2[3].z, s2[3].w))));
            x1 = xmax16(x1); x1 = xmax32(x1); x2 = xmax16(x2); x2 = xmax32(x2);
            const float sc = near ? 1.0f : CS, cb = near ? 0.0f : c15;
            const float cand1 = x1 * sc + cb, cand2 = x2 * sc + cb;
            if (__builtin_amdgcn_ballot_w64(cand1 > m1 + 8.0f) != 0ull) { const float mn = fmaxf(m1, cand1), al = __builtin_amdgcn_exp2f(m1 - mn); m1 = mn; l1 *= al;
#pragma unroll
                for (int d = 0; d < 8; ++d) o1[d] = o1[d] * al; }
            if (__builtin_amdgcn_ballot_w64(cand2 > m2 + 8.0f) != 0ull) { const float mn = fmaxf(m2, cand2), al = __builtin_amdgcn_exp2f(m2 - mn); m2 = mn; l2 *= al;
#pragma unroll
                for (int d = 0; d < 8; ++d) o2[d] = o2[d] * al; }
            const float of1 = cb - m1, of2 = cb - m2;
            float r1 = 0.f, r2 = 0.f;
#pragma unroll
            for (int kt = 0; kt < 4; ++kt) {
                s1[kt].x = __builtin_amdgcn_exp2f(s1[kt].x * sc + of1); s1[kt].y = __builtin_amdgcn_exp2f(s1[kt].y * sc + of1); s1[kt].z = __builtin_amdgcn_exp2f(s1[kt].z * sc + of1); s1[kt].w = __builtin_amdgcn_exp2f(s1[kt].w * sc + of1);
                s2[kt].x = __builtin_amdgcn_exp2f(s2[kt].x * sc + of2); s2[kt].y = __builtin_amdgcn_exp2f(s2[kt].y * sc + of2); s2[kt].z = __builtin_amdgcn_exp2f(s2[kt].z * sc + of2); s2[kt].w = __builtin_amdgcn_exp2f(s2[kt].w * sc + of2);
                r1 += (s1[kt].x + s1[kt].y) + (s1[kt].z + s1[kt].w); r2 += (s2[kt].x + s2[kt].y) + (s2[kt].z + s2[kt].w);
            }
            l1 += r1; l2 += r2;
            bf16x8 p1[2], p2[2];
#pragma unroll
            for (int st = 0; st < 2; ++st) {
                u32x4 a; a.x = cvt_pk_bf16(s1[2 * st].x, s1[2 * st].y); a.y = cvt_pk_bf16(s1[2 * st].z, s1[2 * st].w); a.z = cvt_pk_bf16(s1[2 * st + 1].x, s1[2 * st + 1].y); a.w = cvt_pk_bf16(s1[2 * st + 1].z, s1[2 * st + 1].w);
                u32x4 c; c.x = cvt_pk_bf16(s2[2 * st].x, s2[2 * st].y); c.y = cvt_pk_bf16(s2[2 * st].z, s2[2 * st].w); c.z = cvt_pk_bf16(s2[2 * st + 1].x, s2[2 * st + 1].y); c.w = cvt_pk_bf16(s2[2 * st + 1].z, s2[2 * st + 1].w);
                p1[st] = mk8(a); p2[st] = mk8(c);
            }
#pragma unroll
            for (int d = 0; d < 8; ++d)
#pragma unroll
                for (int st = 0; st < 2; ++st) {
                    const s16x4 lo = vtr(Vb + (32 * st) * AV_STRIDE + d * 32), hi = vtr(Vb + (32 * st + 16) * AV_STRIDE + d * 32);
                    const bf16x8 vf = (bf16x8){lo[0], lo[1], lo[2], lo[3], hi[0], hi[1], hi[2], hi[3]};
                    o1[d] = MFMA16(vf, p1[st], o1[d]); o2[d] = MFMA16(vf, p2[st], o2[d]);
                }
        }
        if (more) { const int bo = ((j + 1) & 1);
            *(LAS u32x4*)(lds + bo * AK_BYTES + srow * AK_STRIDE + sch * 16) = sk0; *(LAS u32x4*)(lds + bo * AK_BYTES + (srow + 32) * AK_STRIDE + sch * 16) = sk1;
            *(LAS u32x4*)(lds + AV_OFF + bo * AV_BYTES + srow * AV_STRIDE + sch * 16) = sv0; *(LAS u32x4*)(lds + AV_OFF + bo * AV_BYTES + (srow + 32) * AV_STRIDE + sch * 16) = sv1; }
        __syncthreads();
    }
    l1 += __shfl_xor(l1, 16); l1 += __shfl_xor(l1, 32); l2 += __shfl_xor(l2, 16); l2 += __shfl_xor(l2, 32);
    const float i1 = 1.0f / l1, i2 = lam_full / l2;
    float ss = 0.f;
#pragma unroll
    for (int d = 0; d < 8; ++d) { o1[d] = o1[d] * i1 - o2[d] * i2; ss += dot4(o1[d]); }
    ss += __shfl_xor(ss, 16); ss += __shfl_xor(ss, 32);
    const float rs = (1.0f / sqrtf(ss * (1.f / 128.f) + EPS)) * (1.0f - lambda_init);
    const size_t t = rowbase + qpos;
#pragma unroll
    for (int d = 0; d < 8; ++d) { const int dv = 16 * d + 4 * fq; const int col = h * 128 + dv;
        const f32x4 sg = *(const f32x4*)(subg + dv); const u32x2 gg = *(const u32x2*)(bg + t * BW + col);
        const f32x4 v = o1[d] * rs * sg * (f32x4){bf_lo(gg.x), bf_hi(gg.x), bf_lo(gg.y), bf_hi(gg.y)};
        u32x2 w; w.x = cvt_pk_bf16(v.x, v.y); w.y = cvt_pk_bf16(v.z, v.w); *(u32x2*)(y1 + t * YW + col) = w; }
}

#define XB_TMO      128
#define XB_XCNT(j)  (256  + 64 * (j))
#define XB_XSUB(j)  (1280 + 64 * (j))
#define XB_XGEN(j)  (2304 + 64 * (j))
#define XB_TOP      3328
#define XB_TOPGEN   3392
#define XCD_BAR_WORDS 3456
#define XB_SPIN_CAP (1u << 18)

__device__ __forceinline__ unsigned xb_ld(unsigned* p)              { return __hip_atomic_load(p, __ATOMIC_RELAXED, __HIP_MEMORY_SCOPE_AGENT); }
__device__ __forceinline__ unsigned xb_add(unsigned* p, unsigned v) { return __hip_atomic_fetch_add(p, v, __ATOMIC_RELAXED, __HIP_MEMORY_SCOPE_AGENT); }
__device__ __forceinline__ unsigned xb_xcc_id() { return (unsigned)__builtin_amdgcn_s_getreg((3 << 11) | 20) & 0xFu; }
#define XB_SPIN(cond, bar) do { unsigned _sp = 0; while (cond) { __builtin_amdgcn_s_sleep(1); \
    if ((++_sp & 255u) == 0u) { if (xb_ld(&(bar)[XB_TMO])) break; if (_sp > XB_SPIN_CAP) { atomicAdd(&(bar)[XB_TMO], 1u); break; } } } } while (0)

struct XcdBarrier {
    unsigned* bar; unsigned x;
    volatile LAS unsigned* st;
};

__device__ __forceinline__ XcdBarrier xcd_barrier_post(unsigned* bar, volatile LAS unsigned* st) {
    XcdBarrier b; b.bar = bar; b.x = xb_xcc_id(); b.st = st;
    if (threadIdx.x == 0) (void)xb_add(&bar[XB_XCNT(b.x)], 1u);
    return b;
}
__device__ __forceinline__ void xcd_barrier_complete(unsigned* bar, unsigned x, unsigned& nloc, unsigned& nx) {
    const unsigned G = gridDim.x * gridDim.y * gridDim.z;
    unsigned sum, cnt, mine, sp = 0u;
    for (;;) {
        sum = 0u; cnt = 0u; mine = 0u;
#pragma unroll
        for (unsigned j = 0; j < 16; ++j) { const unsigned c = xb_ld(&bar[XB_XCNT(j)]); sum += c; cnt += (c > 0u) ? 1u : 0u; mine = (j == x) ? c : mine; }
        if (sum == G) break;
        __builtin_amdgcn_s_sleep(1);
        if ((++sp & 255u) == 0u) { if (xb_ld(&bar[XB_TMO])) break; if (sp > XB_SPIN_CAP) { atomicAdd(&bar[XB_TMO], 1u); break; } }
    }
    nloc = mine > 0u ? mine : 1u; nx = cnt > 0u ? cnt : 1u;
}

__device__ __forceinline__ void xcd_barrier(const XcdBarrier& b) {
    asm volatile("s_waitcnt vmcnt(0)" ::: "memory");
    __syncthreads();
    if (threadIdx.x == 0) {
        unsigned* bar = b.bar;
        __builtin_amdgcn_s_waitcnt(0);
        unsigned nloc = b.st[0], nx = b.st[1];
        if (nloc == 0u) { xcd_barrier_complete(bar, b.x, nloc, nx); b.st[0] = nloc; b.st[1] = nx; }
        const unsigned old = xb_add(&bar[XB_XSUB(b.x)], 1u);
        const unsigned gen = old / nloc;
        if (old + 1u == (gen + 1u) * nloc) {
            __builtin_amdgcn_fence(__ATOMIC_RELEASE, "agent");
            asm volatile("s_waitcnt vmcnt(0)" ::: "memory");
            const unsigned og = xb_add(&bar[XB_TOP], 1u);
            const unsigned tg = og / nx;
            if (og + 1u == (tg + 1u) * nx) xb_add(&bar[XB_TOPGEN], 1u);
            else XB_SPIN(xb_ld(&bar[XB_TOPGEN]) == tg, bar);
            __builtin_amdgcn_fence(__ATOMIC_ACQUIRE, "agent");
            xb_add(&bar[XB_XGEN(b.x)], 1u);
            asm volatile("s_waitcnt vmcnt(0)" ::: "memory");
        } else {
            XB_SPIN(xb_ld(&bar[XB_XGEN(b.x)]) == gen, bar);
            __builtin_amdgcn_fence(__ATOMIC_ACQUIRE, "agent");
            asm volatile("s_waitcnt vmcnt(0)" ::: "memory");
        }
    }
    __syncthreads();
}

#define GSYNC() do { xcd_barrier(xb); if (REP_MASK & 16) xcd_barrier(xb); } while (0)
constexpr int MISC_OFF = 131072 + 256;
constexpr int QCTR_WORD = 4096;
#ifndef DEFER_REDUNDANT
#define DEFER_REDUNDANT 1
#endif
#ifndef DEFER_FIRST
#define DEFER_FIRST 0
#endif
#ifndef DEFER_COLS
#define DEFER_COLS 0
#endif
struct DeferOrder { int idx; __device__ bool next(int i, pg8::Unit& u) const { if (i > 0 || idx < 0 || idx >= 96) return false; u.pm = idx & 31; u.pn = 48 + (idx >> 5); return true; }
    __device__ __forceinline__ void a_ready(const pg8::Unit&) const {} __device__ __forceinline__ void done(const pg8::Unit&) const {} };

__global__ void __launch_bounds__(NTHR) mega_fwd(Params p) {
    extern __shared__ __attribute__((aligned(16))) unsigned char lds_raw[];
    cg::grid_group grid = cg::this_grid();
    LAS unsigned char* lds = (LAS unsigned char*)lds_raw;
    const int G = gridDim.x, bx = blockIdx.x;
    const int vcu = (G % 8 == 0) ? (bx % 8) * (G / 8) + bx / 8 : bx;
    unsigned char* ws = p.ws;
    bf16_t* H = (bf16_t*)(ws + WS_H); bf16_t* PROJ = (bf16_t*)(ws + WS_PROJ); bf16_t* GATES = (bf16_t*)(ws + WS_GATES); bf16_t* Y = (bf16_t*)(ws + WS_Y);
    bf16_t* MERGED = (bf16_t*)(ws + WS_MERGED); float* OUTB = (float*)(ws + WS_OUT);
    const size_t SEC = (size_t)M * BW;

    unsigned* barw = (unsigned*)ws;
    { int t0 = threadIdx.x; if (bx == 0) { for (int i = t0; i < XCD_BAR_WORDS; i += NTHR) barw[i] = 0u; if (t0 < DEPTH) barw[QCTR_WORD + 64 * t0] = (unsigned)G; }
      if (t0 < 4) ((volatile LAS unsigned*)(lds + MISC_OFF))[t0] = 0u; }
    __syncthreads();
    prologue(p, lds, vcu, G);
    grid.sync();
    XcdBarrier xb = xcd_barrier_post(barw, (volatile LAS unsigned*)(lds + MISC_OFF));

    for (int l = 0; l < DEPTH; ++l) {
        const float lambda_init = 0.8f - 0.6f * __expf(-0.3f * (float)l);
#ifndef NO_G1
        for (int rep = 0; rep < ((REP_MASK & 4) ? 2 : 1); ++rep)
        { pg8::Gemm g{H, (const bf16_t*)(ws + WS_W1T + l * SZ_W1T), M, N1, DM}; pg8::StaticOrder S; S.init(M, N1 - (DEFER_REDUNDANT ? 0 : DEFER_COLS), G, bx);
          pg8::EpiG1 E{PROJ, GATES};
          pg8::gemm_phase<pg8::EpiG1, pg8::StaticOrder, true, true>(lds, g, S, E); }
#endif
        GSYNC();
        {
          for (int rep = 0; rep < ((REP_MASK & 1) ? 2 : 1); ++rep)
          for (int r = 0;; ++r) { const int u = r * G + ((r & 1) ? (G - 1 - vcu) : vcu); if (u >= 384) break;
              attn_unit(lds, u % 12, 31 - u / 12, PROJ + 2 * SEC, PROJ + 3 * SEC, PROJ + 4 * SEC, PROJ + 5 * SEC, p.rel_bias, p.lam + l * 256, p.subln_g + l * 128, lambda_init, Y + BW); }
          if (G == 256) {
              for (int rep = 0; rep < ((REP_MASK & 2) ? 2 : 1); ++rep)
#pragma unroll 1
              for (int r = 0; r < 4; ++r) { const int st = (r < 2) ? 64 : (r == 2 ? 96 : 160), off = (r == 0) ? 0 : (r == 1 ? 192 : (r == 2 ? 384 : 544));
                  if (vcu < st) continue; const int j = off + (vcu - st);
                  if (j < 384) sgu_unit(lds, j, PROJ + 6 * SEC, PROJ + 7 * SEC, PROJ + 8 * SEC, p.sgu_ng + l * BW, p.sgu_nb + l * BW, p.sgu_w + (size_t)l * 6 * 128 * 128, p.sgu_b + l * 6 * 128, Y + 2 * BW);
                  else pool_unit(lds, j - 384, PROJ, PROJ + SEC, (const bf16_t*)(ws + WS_WPT + l * SZ_WPT), p.pool_scale + l * BW, Y); }
          } else {
              for (int j = vcu; j < 640; j += G) {
                  if (j < 384) sgu_unit(lds, j, PROJ + 6 * SEC, PROJ + 7 * SEC, PROJ + 8 * SEC, p.sgu_ng + l * BW, p.sgu_nb + l * BW, p.sgu_w + (size_t)l * 6 * 128 * 128, p.sgu_b + l * 6 * 128, Y + 2 * BW);
                  else pool_unit(lds, j - 384, PROJ, PROJ + SEC, (const bf16_t*)(ws + WS_WPT + l * SZ_WPT), p.pool_scale + l * BW, Y); }
          }
        }
        GSYNC();
#ifndef NO_G2
        for (int rep = 0; rep < ((REP_MASK & 8) ? 2 : 1); ++rep)
        { pg8::Gemm g{Y, (const bf16_t*)(ws + WS_WBT + l * SZ_WBT), M, DM, YW}; pg8::StaticOrder S; S.init(M, DM, G, bx);
          pg8::EpiG2h E{GATES, MERGED};
          pg8::gemm_phase<pg8::EpiG2h, pg8::StaticOrder, true, true>(lds, g, S, E); }
#endif
        GSYNC();
#ifndef NO_G3
        for (int rep = 0; rep < ((REP_MASK & 8) ? 2 : 1); ++rep)
        { pg8::Gemm g{MERGED, (const bf16_t*)(ws + WS_WOT + l * SZ_WOT), M, DM, DM}; pg8::StaticOrder S; S.init(M, DM, G, bx);
          pg8::EpiG3 E{OUTB};
          pg8::gemm_phase<pg8::EpiG3, pg8::StaticOrder, true, true>(lds, g, S, E); }
#endif
        GSYNC();
        rowpass(l == 0 ? p.x : p.out, p.out, OUTB, p.g_post + l * DM, (l + 1 < DEPTH) ? p.g_pre + (l + 1) * DM : nullptr, H, vcu, G);
        if (l + 1 < DEPTH) GSYNC();
    }
}

extern "C" void kernel_launch(void* const* d_in, const int* in_sizes, int n_in, void* d_out, int out_size, void* d_ws, size_t ws_size, hipStream_t stream) {
    static int grid = 0;
    if (grid == 0) {
        if (n_in != 16 || in_sizes[0] != M * DM || out_size != M * DM || ws_size < WS_END) { fprintf(stderr, "kernel_launch: unexpected shapes / workspace (%zu < %zu); nothing launched\n", ws_size, (size_t)WS_END); grid = -1; return; }
        int dev = 0, cus = 0, per_cu = 0;
        hipGetDevice(&dev); hipDeviceGetAttribute(&cus, hipDeviceAttributeMultiprocessorCount, dev);
        if (hipFuncSetAttribute((const void*)mega_fwd, hipFuncAttributeMaxDynamicSharedMemorySize, LDS_BYTES) != hipSuccess) { fprintf(stderr, "kernel_launch: hipFuncSetAttribute failed\n"); grid = -1; return; }
        if (hipOccupancyMaxActiveBlocksPerMultiprocessor(&per_cu, (const void*)mega_fwd, NTHR, LDS_BYTES) != hipSuccess || per_cu < 1) { fprintf(stderr, "kernel_launch: occupancy query failed (%d)\n", per_cu); (void)hipGetLastError(); per_cu = 1; }
        grid = cus * per_cu;
    }
    if (grid < 0) return;
    Params p{};
    p.x = (const float*)d_in[0]; p.rel_bias = (const float*)d_in[1]; p.g_pre = (const float*)d_in[2]; p.w_in = (const float*)d_in[3]; p.w_gate = (const float*)d_in[4];
    p.pool_w = (const float*)d_in[5]; p.pool_scale = (const float*)d_in[6]; p.lam = (const float*)d_in[7]; p.subln_g = (const float*)d_in[8]; p.sgu_ng = (const float*)d_in[9];
    p.sgu_nb = (const float*)d_in[10]; p.sgu_w = (const float*)d_in[11]; p.sgu_b = (const float*)d_in[12]; p.w_branch = (const float*)d_in[13]; p.w_out = (const float*)d_in[14]; p.g_post = (const float*)d_in[15];
    p.out = (float*)d_out; p.ws = (unsigned char*)d_ws;
    void* args[] = {&p};
    hipError_t e = hipLaunchCooperativeKernel((const void*)mega_fwd, dim3(grid), dim3(NTHR), args, LDS_BYTES, stream);
    if (e != hipSuccess) fprintf(stderr, "cooperative launch failed: %s (grid %d)\n", hipGetErrorString(e), grid);
}
```

```cpp
#include <hip/hip_runtime.h>
#include <hip/hip_cooperative_groups.h>
#include <cstdio>
#include <cstdint>
namespace cg = cooperative_groups;
#ifndef REP_MASK
#define REP_MASK 0
#endif
namespace pg8 {
#define PG8_LAS __attribute__((address_space(3)))
typedef unsigned short bf16_t;
typedef short bf16x8 __attribute__((ext_vector_type(8)));
typedef float f32x4 __attribute__((ext_vector_type(4)));
typedef unsigned u32x4 __attribute__((ext_vector_type(4)));
constexpr int BM = 256, BK = 64, HALF = 128, HTB = HALF * BK * 2  , STAGE_BYTES = 8 * HTB, NXCD = 8, WGM = 8;

__host__ __device__ __forceinline__ int lds_byte(int r, int c) { const int st = (r >> 4) * 2 + (c >> 5), rr = r & 15, cc = c & 31, ob = rr * 64 + cc * 2; return st * 1024 + (ob ^ (((ob >> 9) & 1) << 5)); }
__host__ __device__ __forceinline__ void stage_rc(int b, int& R, int& C) { const int st = b / 1024, sb = b % 1024, swz = sb ^ (((sb >> 9) & 1) << 5); R = (st >> 1) * 16 + swz / 64; C = (st & 1) * 32 + (swz % 64) / 2; }
__host__ __device__ __forceinline__ int perm32(int rho) { const int n = rho >> 4, i = rho & 15; return 8 * (i >> 2) + 4 * n + (i & 3); }

struct Unit { int pm, pn; };
struct Gemm { const bf16_t* A; const bf16_t* Bt; int M, N, K; };

struct StaticOrder {
    int nM, nN, nwg, G, c;
    __host__ __device__ void init(int M, int N, int G_, int c_) { nM = M / BM; nN = N / BM; nwg = nM * nN; G = G_; c = c_; }
    __host__ __device__ bool next(int i, Unit& u) const {
        const long L = (long)i * G + c; if (L >= nwg) return false;
        int wgid = (int)L; { const int q = nwg / NXCD, r = nwg % NXCD, xcd = wgid % NXCD, off = wgid / NXCD; wgid = (xcd < r ? xcd * (q + 1) : r * (q + 1) + (xcd - r) * q) + off; }
        const int nig = WGM * nN, gid = wgid / nig, fm = gid * WGM, gsz = (nM - fm) < WGM ? (nM - fm) : WGM;
        u.pm = fm + ((wgid % nig) % gsz); u.pn = (wgid % nig) / gsz; return true;
    }
    __device__ __forceinline__ void a_ready(const Unit&) const {}
    __device__ __forceinline__ void done(const Unit&) const {}
};

__device__ __forceinline__ unsigned cvt_pk_bf16(float lo, float hi) { unsigned r; asm volatile("v_cvt_pk_bf16_f32 %0, %1, %2" : "=v"(r) : "v"(lo), "v"(hi)); return r; }
typedef float f32x2 __attribute__((ext_vector_type(2)));
__device__ __forceinline__ f32x2 gelu_pk(f32x2 v) {
    const f32x2 av = __builtin_elementwise_abs(v), d = av * 0.2316418882f + 1.0f;
    f32x2 t; t.x = __builtin_amdgcn_rcpf(d.x); t.y = __builtin_amdgcn_rcpf(d.y);
    f32x2 q = t * 0.5307027145f + (-0.7265760135f); q = q * t + 0.7107068705f; q = q * t + (-0.142248368f); q = q * t + 0.127414796f; q = q * t;
    const f32x2 s = (v * v) * (-0.72134752044f);
    f32x2 e; e.x = __builtin_amdgcn_exp2f(s.x); e.y = __builtin_amdgcn_exp2f(s.y);
    const f32x2 m = v * (q * e), r = v - m;
    f32x2 o; o.x = v.x < 0.f ? m.x : r.x; o.y = v.y < 0.f ? m.y : r.y; return o;
}


__device__ __forceinline__ float bf_lo(unsigned u) { return __uint_as_float(u << 16); }
__device__ __forceinline__ float bf_hi(unsigned u) { return __uint_as_float(u & 0xffff0000u); }
__device__ __forceinline__ float act_sig(float x, float na, float nb, bool mulx) {
    const float z = x * (na + nb * x * x);
    const float s = __builtin_amdgcn_rcpf(1.0f + __builtin_amdgcn_exp2f(z));
    return mulx ? x * s : fmaxf(s, 1e-18f);
}
constexpr int TOK = 8192, BRW = 768, NGATE = 6144, DMODEL = 2048;
struct EpiG1 {
    static constexpr bool PERM = true, AFTER_DRAIN = false, MID = false;
    bf16_t* proj; bf16_t* gates;
    __device__ __forceinline__ void operator()(const f32x4 (&acc)[2][2][4][2], const Unit& u, int wr, int wc, int fr, int fq) const {
        const int row0 = u.pm * BM + wr * 64 + fr; const int pn = u.pn;
        bf16_t* base; int ldc, colt, act;
        if (pn < 27) { const int s = pn / 3; base = proj + (size_t)s * TOK * BRW; ldc = BRW; colt = (pn - 3 * s) * BM; act = (s == 1 || s == 5 || s == 8) ? 1 : ((s == 6 || s == 7) ? 2 : 0); }
        else { base = gates; ldc = NGATE; colt = (pn - 27) * BM; act = 3; }
        const int col0 = colt + wc * 32 + 8 * fq;
        if (act == 0) {
#pragma unroll
            for (int ai = 0; ai < 2; ++ai)
#pragma unroll
                for (int m = 0; m < 4; ++m) { bf16_t* rowp = base + (size_t)(row0 + ai * HALF + m * 16) * ldc + col0;
#pragma unroll
                    for (int bj = 0; bj < 2; ++bj) { const f32x4 v0 = acc[ai][bj][m][0], v1 = acc[ai][bj][m][1];
                        u32x4 w; w.x = cvt_pk_bf16(v0[0], v0[1]); w.y = cvt_pk_bf16(v0[2], v0[3]); w.z = cvt_pk_bf16(v1[0], v1[1]); w.w = cvt_pk_bf16(v1[2], v1[3]);
                        *(u32x4*)(rowp + bj * HALF) = w; } }
        } else {
            const float L2E = 1.4426950408889634f;
            const float na = (act == 2) ? -L2E * 1.5957691216057308f : -L2E, nb = (act == 2) ? -L2E * 1.5957691216057308f * 0.044715f : 0.f; const bool mulx = (act != 3);
#pragma unroll
            for (int ai = 0; ai < 2; ++ai)
#pragma unroll
                for (int m = 0; m < 4; ++m) { bf16_t* rowp = base + (size_t)(row0 + ai * HALF + m * 16) * ldc + col0;
#pragma unroll
                    for (int bj = 0; bj < 2; ++bj) { const f32x4 v0 = acc[ai][bj][m][0], v1 = acc[ai][bj][m][1];
                        u32x4 w; w.x = cvt_pk_bf16(act_sig(v0[0], na, nb, mulx), act_sig(v0[1], na, nb, mulx)); w.y = cvt_pk_bf16(act_sig(v0[2], na, nb, mulx), act_sig(v0[3], na, nb, mulx));
                        w.z = cvt_pk_bf16(act_sig(v1[0], na, nb, mulx), act_sig(v1[1], na, nb, mulx)); w.w = cvt_pk_bf16(act_sig(v1[2], na, nb, mulx), act_sig(v1[3], na, nb, mulx));
                        *(u32x4*)(rowp + bj * HALF) = w; } }
        }
    }
};
struct EpiG2 {
    static constexpr bool PERM = true, AFTER_DRAIN = false, MID = false;
    const bf16_t* gates; float* part; bf16_t* merged;
    __device__ __forceinline__ void operator()(const f32x4 (&acc)[2][2][4][2], const Unit& u, int wr, int wc, int fr, int fq) const {
        const int n = u.pm >> 5, pm = u.pm & 31, pn = u.pn & 7;
        const int row0 = pm * BM + wr * 64 + fr, col0 = pn * BM + wc * 32 + 8 * fq;
#pragma unroll
        for (int ai = 0; ai < 2; ++ai)
#pragma unroll
            for (int m = 0; m < 4; ++m) { const size_t r = (size_t)(row0 + ai * HALF + m * 16);
#pragma unroll
                for (int bj = 0; bj < 2; ++bj) { const int c = col0 + bj * HALF;
                    const u32x4 g = *(const u32x4*)(gates + r * NGATE + n * DMODEL + c);
                    f32x4 v0 = acc[ai][bj][m][0], v1 = acc[ai][bj][m][1];
                    v0[0] *= bf_lo(g.x); v0[1] *= bf_hi(g.x); v0[2] *= bf_lo(g.y); v0[3] *= bf_hi(g.y); v1[0] *= bf_lo(g.z); v1[1] *= bf_hi(g.z); v1[2] *= bf_lo(g.w); v1[3] *= bf_hi(g.w);
                    float* pp = part + r * DMODEL + c;
                    if (n == 0) { *(f32x4*)pp = v0; *(f32x4*)(pp + 4) = v1; }
                    else { v0 += *(const f32x4*)pp; v1 += *(const f32x4*)(pp + 4);
                        if (n == 1) { *(f32x4*)pp = v0; *(f32x4*)(pp + 4) = v1; }
                        else { u32x4 w; w.x = cvt_pk_bf16(v0[0], v0[1]); w.y = cvt_pk_bf16(v0[2], v0[3]); w.z = cvt_pk_bf16(v1[0], v1[1]); w.w = cvt_pk_bf16(v1[2], v1[3]); *(u32x4*)(merged + r * DMODEL + c) = w; } }
                } }
    }
};
struct G2Order {
    int G, c;
    __device__ bool next(int i, Unit& u) const { const int k = i / 3, n = i - 3 * k; const int pr = c + k * G; if (pr >= 256) return false; u.pm = n * 32 + (pr >> 3); u.pn = n * 8 + (pr & 7); return true; }
    __device__ __forceinline__ void a_ready(const Unit&) const {}
    __device__ __forceinline__ void done(const Unit&) const {}
};
struct EpiG3 {
    static constexpr bool PERM = true, AFTER_DRAIN = false, MID = false;
    float* out;
    __device__ __forceinline__ void operator()(const f32x4 (&acc)[2][2][4][2], const Unit& u, int wr, int wc, int fr, int fq) const {
        const int row0 = u.pm * BM + wr * 64 + fr, col0 = u.pn * BM + wc * 32 + 8 * fq;
#pragma unroll
        for (int ai = 0; ai < 2; ++ai)
#pragma unroll
            for (int m = 0; m < 4; ++m) { float* rowp = out + (size_t)(row0 + ai * HALF + m * 16) * DMODEL + col0;
#pragma unroll
                for (int bj = 0; bj < 2; ++bj) { *(f32x4*)(rowp + bj * HALF) = acc[ai][bj][m][0]; *(f32x4*)(rowp + bj * HALF + 4) = acc[ai][bj][m][1]; } }
    }
};

struct EpiG2h {
    static constexpr bool PERM = true, AFTER_DRAIN = false, MID = true;
    const bf16_t* gates; bf16_t* merged;
    __device__ __forceinline__ void mid(f32x4 (&acc)[2][2][4][2], const Unit& u, int s, int wr, int wc, int fr, int fq) const {
        int row0 = u.pm * BM + wr * 64 + fr; const int col0 = u.pn * BM + wc * 32 + 8 * fq;
        asm volatile("" : "+v"(row0));
#pragma unroll
        for (int ai = 0; ai < 2; ++ai)
#pragma unroll
            for (int m = 0; m < 4; ++m) { const bf16_t* gp = gates + (size_t)(row0 + ai * HALF + m * 16) * NGATE + (s - 1) * DMODEL + col0;
#pragma unroll
                for (int bj = 0; bj < 2; ++bj) { const u32x4 a = *(const u32x4*)(gp + bj * HALF), b = *(const u32x4*)(gp + DMODEL + bj * HALF);
                    f32x4 r0, r1;
                    r0[0] = bf_lo(a.x) * __builtin_amdgcn_rcpf(bf_lo(b.x)); r0[1] = bf_hi(a.x) * __builtin_amdgcn_rcpf(bf_hi(b.x)); r0[2] = bf_lo(a.y) * __builtin_amdgcn_rcpf(bf_lo(b.y)); r0[3] = bf_hi(a.y) * __builtin_amdgcn_rcpf(bf_hi(b.y));
                    r1[0] = bf_lo(a.z) * __builtin_amdgcn_rcpf(bf_lo(b.z)); r1[1] = bf_hi(a.z) * __builtin_amdgcn_rcpf(bf_hi(b.z)); r1[2] = bf_lo(a.w) * __builtin_amdgcn_rcpf(bf_lo(b.w)); r1[3] = bf_hi(a.w) * __builtin_amdgcn_rcpf(bf_hi(b.w));
                    acc[ai][bj][m][0] *= r0; acc[ai][bj][m][1] *= r1; asm volatile("" ::: "memory"); } }
    }
    __device__ __forceinline__ void operator()(const f32x4 (&acc)[2][2][4][2], const Unit& u, int wr, int wc, int fr, int fq) const {
        const int row0 = u.pm * BM + wr * 64 + fr, col0 = u.pn * BM + wc * 32 + 8 * fq;
#pragma unroll
        for (int ai = 0; ai < 2; ++ai)
#pragma unroll
            for (int m = 0; m < 4; ++m) { const size_t r = (size_t)(row0 + ai * HALF + m * 16);
#pragma unroll
                for (int bj = 0; bj < 2; ++bj) { const int c = col0 + bj * HALF;
                    const u32x4 g = *(const u32x4*)(gates + r * NGATE + 2 * DMODEL + c);
                    const f32x4 v0 = acc[ai][bj][m][0], v1 = acc[ai][bj][m][1];
                    u32x4 w; w.x = cvt_pk_bf16(v0[0] * bf_lo(g.x), v0[1] * bf_hi(g.x)); w.y = cvt_pk_bf16(v0[2] * bf_lo(g.y), v0[3] * bf_hi(g.y));
                    w.z = cvt_pk_bf16(v1[0] * bf_lo(g.z), v1[1] * bf_hi(g.z)); w.w = cvt_pk_bf16(v1[2] * bf_lo(g.w), v1[3] * bf_hi(g.w));
                    *(u32x4*)(merged + r * DMODEL + c) = w; } }
    }
};
template <class Epi, class Sched, bool ALIGN_EPI = false, bool SP2 = false>
__device__ __forceinline__ void gemm_phase(PG8_LAS unsigned char* lds, const Gemm g, const Sched& S, const Epi& E) {
    int tid_ = threadIdx.x; asm volatile("" : "+v"(tid_));
    const int tid = tid_, wid = __builtin_amdgcn_readfirstlane(tid >> 6), lane = tid & 63, wr = wid >> 2, wc = wid & 3, fr = lane & 15, fq = lane >> 4;
    const int K = g.K, nt = K / BK;
    unsigned voffA[2], voffB[2];
#pragma unroll
    for (int i = 0; i < 2; ++i) { int R, C; stage_rc(tid * 16 + i * 8192, R, C); const int Rb = Epi::PERM ? ((R & ~31) + perm32(R & 31)) : R;
        voffA[i] = (unsigned)(R * K + C) * 2u; voffB[i] = (unsigned)(Rb * K + C) * 2u; }
    const size_t kstep = (size_t)(BK * 2);
    const size_t hstep = (size_t)HALF * K * 2;
    const size_t tstep = 2 * hstep;
    const unsigned ldsw = (unsigned)wid * 1024u;
    const int aoff = lds_byte(wr * 64 + fr, fq * 8), boff = lds_byte(wc * 32 + fr, fq * 8);
#define PG8_SA(b, h) (((b) * 2 + (h)) * HTB)
#define PG8_SB(b, h) ((4 + (b) * 2 + (h)) * HTB)
#define PG8_STAGE(bufoff, gbase, voff) do { _Pragma("unroll") for (int _i = 0; _i < 2; ++_i) \
        __builtin_amdgcn_global_load_lds((const unsigned*)((const char*)(gbase) + (voff)[_i]), (PG8_LAS unsigned*)(lds + (bufoff) + ldsw + _i * 8192), 16, 0, 0); } while (0)
#define PG8_LDA(dst, b, h) do { _Pragma("unroll") for (int m = 0; m < 4; ++m) _Pragma("unroll") for (int k = 0; k < 2; ++k) dst[m][k] = *(const PG8_LAS bf16x8*)(lds + PG8_SA(b, h) + aoff + m * 2048 + k * 1024); } while (0)
#define PG8_LDB(dst, b, h) do { _Pragma("unroll") for (int n = 0; n < 2; ++n) _Pragma("unroll") for (int k = 0; k < 2; ++k) dst[n][k] = *(const PG8_LAS bf16x8*)(lds + PG8_SB(b, h) + boff + n * 2048 + k * 1024); } while (0)
#define PG8_MMA(ai, bj, At, Bt) do { __builtin_amdgcn_s_setprio(1); _Pragma("unroll") for (int m = 0; m < 4; ++m) _Pragma("unroll") for (int n = 0; n < 2; ++n) _Pragma("unroll") for (int k = 0; k < 2; ++k) \
        acc[ai][bj][m][n] = __builtin_amdgcn_mfma_f32_16x16x32_bf16(Bt[n][k], At[m][k], acc[ai][bj][m][n], 0, 0, 0); __builtin_amdgcn_s_setprio(0); } while (0)
#define PG8_WAIT_V(n) asm volatile("s_waitcnt vmcnt(" #n ")" ::: "memory")
#define PG8_WAIT_L(n) asm volatile("s_waitcnt lgkmcnt(" #n ")" ::: "memory")
#define PG8_BAR __builtin_amdgcn_s_barrier()
#define PG8_SCHED __builtin_amdgcn_sched_barrier(0)
    Unit cur, nxt; int ui = 0;
    if (!S.next(0, cur)) return;
    f32x4 acc[2][2][4][2];
#pragma unroll
    for (int a = 0; a < 2; ++a)
#pragma unroll
        for (int b = 0; b < 2; ++b)
#pragma unroll
            for (int m = 0; m < 4; ++m)
#pragma unroll
                for (int n = 0; n < 2; ++n) acc[a][b][m][n] = (f32x4){0.f, 0.f, 0.f, 0.f};
    bf16x8 At[4][2], B0[2][2], B1[2][2];
    const char* cA = (const char*)g.A + (size_t)cur.pm * tstep; const char* cB = (const char*)g.Bt + (size_t)cur.pn * tstep;
    S.a_ready(cur);
    if constexpr (SP2) {
        PG8_STAGE(PG8_SB(0, 0), cB, voffB); PG8_STAGE(PG8_SB(0, 1), cB + hstep, voffB); PG8_STAGE(PG8_SA(0, 0), cA, voffA); PG8_STAGE(PG8_SA(0, 1), cA + hstep, voffA);
        if (wr == 1) PG8_BAR;
        PG8_WAIT_V(2); PG8_BAR;
        PG8_STAGE(PG8_SB(1, 0), cB + kstep, voffB); PG8_STAGE(PG8_SA(1, 0), cA + kstep, voffA); PG8_STAGE(PG8_SB(1, 1), cB + hstep + kstep, voffB);
        PG8_WAIT_V(6); PG8_BAR;
    } else {
        PG8_STAGE(PG8_SB(0, 0), cB, voffB); PG8_STAGE(PG8_SA(0, 0), cA, voffA); PG8_STAGE(PG8_SB(0, 1), cB + hstep, voffB); PG8_STAGE(PG8_SA(0, 1), cA + hstep, voffA);
        if (wr == 1) PG8_BAR;
        PG8_WAIT_V(4); PG8_BAR;
        PG8_STAGE(PG8_SB(1, 0), cB + kstep, voffB); PG8_STAGE(PG8_SA(1, 0), cA + kstep, voffA); PG8_STAGE(PG8_SB(1, 1), cB + hstep + kstep, voffB);
        PG8_WAIT_V(6); PG8_BAR;
    }
    for (;;) {
        const bool has_next = S.next(ui + 1, nxt);
        const char* nA = has_next ? (const char*)g.A + (size_t)nxt.pm * tstep : cA; const char* nB = has_next ? (const char*)g.Bt + (size_t)nxt.pn * tstep : cB;
        for (int t = 0; t < nt; t += 2) {
            if constexpr (Epi::MID) { if (t == 12 || t == 24) E.mid(acc, cur, t / 12, wr, wc, fr, fq); }
            const bool last = (t == nt - 2);
            const char* a1 = cA + (size_t)(t + 1) * kstep;
            const char* a2 = last ? nA : cA + (size_t)(t + 2) * kstep; const char* b2 = last ? nB : cB + (size_t)(t + 2) * kstep;
            const char* a3 = a2 + kstep; const char* b3 = b2 + kstep;
            if (last && has_next) S.a_ready(nxt);
            if constexpr (SP2) {
            PG8_LDB(B0, 0, 0); PG8_LDB(B1, 0, 1); PG8_SCHED; PG8_LDA(At, 0, 0); PG8_STAGE(PG8_SA(1, 1), a1 + hstep, voffA);
            PG8_WAIT_V(8); PG8_WAIT_L(0); PG8_BAR; PG8_MMA(0, 0, At, B0); PG8_MMA(0, 1, At, B1); PG8_BAR; PG8_SCHED;
            PG8_LDA(At, 0, 1); PG8_STAGE(PG8_SB(0, 0), b2, voffB); PG8_STAGE(PG8_SB(0, 1), b2 + hstep, voffB); PG8_STAGE(PG8_SA(0, 0), a2, voffA);
            PG8_WAIT_V(8); PG8_WAIT_L(0); PG8_BAR; PG8_MMA(1, 0, At, B0); PG8_MMA(1, 1, At, B1); PG8_BAR; PG8_SCHED;
            PG8_LDB(B0, 1, 0); PG8_LDB(B1, 1, 1); PG8_SCHED; PG8_LDA(At, 1, 0); PG8_STAGE(PG8_SA(0, 1), a2 + hstep, voffA);
            PG8_WAIT_V(8); PG8_WAIT_L(0); PG8_BAR; PG8_MMA(0, 0, At, B0); PG8_MMA(0, 1, At, B1); PG8_BAR; PG8_SCHED;
            PG8_LDA(At, 1, 1); PG8_STAGE(PG8_SB(1, 0), b3, voffB); PG8_STAGE(PG8_SB(1, 1), b3 + hstep, voffB); PG8_STAGE(PG8_SA(1, 0), a3, voffA);
            PG8_WAIT_V(8); PG8_WAIT_L(0); PG8_BAR; PG8_MMA(1, 0, At, B0); PG8_MMA(1, 1, At, B1); PG8_BAR; PG8_SCHED;
            } else {
            PG8_LDB(B0, 0, 0); PG8_SCHED; PG8_LDA(At, 0, 0); PG8_STAGE(PG8_SA(1, 1), a1 + hstep, voffA);
            PG8_WAIT_L(8); PG8_BAR; PG8_WAIT_L(0); PG8_MMA(0, 0, At, B0); PG8_BAR; PG8_SCHED;
            PG8_LDB(B1, 0, 1); PG8_STAGE(PG8_SB(0, 0), b2, voffB);
            PG8_BAR; PG8_WAIT_L(0); PG8_MMA(0, 1, At, B1); PG8_BAR;
            PG8_LDA(At, 0, 1); PG8_STAGE(PG8_SA(0, 0), a2, voffA);
            PG8_BAR; PG8_WAIT_L(0); PG8_MMA(1, 0, At, B0); PG8_BAR; PG8_SCHED;
            PG8_STAGE(PG8_SB(0, 1), b2 + hstep, voffB);
            PG8_WAIT_V(6); PG8_BAR; PG8_MMA(1, 1, At, B1); PG8_BAR;
            PG8_LDB(B0, 1, 0); PG8_SCHED; PG8_LDA(At, 1, 0); PG8_STAGE(PG8_SA(0, 1), a2 + hstep, voffA);
            PG8_WAIT_L(8); PG8_BAR; PG8_WAIT_L(0); PG8_MMA(0, 0, At, B0); PG8_BAR; PG8_SCHED;
            PG8_LDB(B1, 1, 1); PG8_STAGE(PG8_SB(1, 0), b3, voffB);
            PG8_BAR; PG8_WAIT_L(0); PG8_MMA(0, 1, At, B1); PG8_BAR;
            PG8_LDA(At, 1, 1); PG8_STAGE(PG8_SA(1, 0), a3, voffA);
            PG8_BAR; PG8_WAIT_L(0); PG8_MMA(1, 0, At, B0); PG8_BAR; PG8_SCHED;
            PG8_STAGE(PG8_SB(1, 1), b3 + hstep, voffB);
            PG8_WAIT_V(6); PG8_BAR; PG8_MMA(1, 1, At, B1); PG8_BAR;
            }
        }
        if constexpr (ALIGN_EPI) { if (wr == 0) PG8_BAR; }
        if constexpr (!Epi::AFTER_DRAIN) { E(acc, cur, wr, wc, fr, fq); S.done(cur); }
        if (!has_next) break;
#pragma unroll
        for (int a = 0; a < 2; ++a)
#pragma unroll
            for (int b = 0; b < 2; ++b)
#pragma unroll
                for (int m = 0; m < 4; ++m)
#pragma unroll
                    for (int n = 0; n < 2; ++n) acc[a][b][m][n] = (f32x4){0.f, 0.f, 0.f, 0.f};
        cur = nxt; cA = nA; cB = nB; ++ui;
        if constexpr (ALIGN_EPI) { if (wr == 1) PG8_BAR; }
    }
    PG8_WAIT_V(0);
    if constexpr (!ALIGN_EPI) { if (wr == 0) PG8_BAR; }
    PG8_BAR;
    if constexpr (Epi::AFTER_DRAIN) { E.fused(acc, cur, wr, wc, fr, fq, lds, wid, lane); S.done(cur); }
#undef PG8_SA
#undef PG8_SB
#undef PG8_STAGE
#undef PG8_LDA
#undef PG8_LDB
#undef PG8_MMA
#undef PG8_WAIT_V
#undef PG8_WAIT_L
#undef PG8_BAR
#undef PG8_SCHED
}
}

#ifndef PG8_SP2
#define PG8_SP2 true
#endif
#ifndef PG8_ALIGN
#define PG8_ALIGN true
#endif

#define LAS __attribute__((address_space(3)))
typedef unsigned short bf16_t;
typedef short bf16x8 __attribute__((ext_vector_type(8)));
typedef short s16x4 __attribute__((ext_vector_type(4)));
typedef float f32x4 __attribute__((ext_vector_type(4)));
typedef float f32x2 __attribute__((ext_vector_type(2)));
typedef unsigned u32x4 __attribute__((ext_vector_type(4)));
typedef unsigned u32x2 __attribute__((ext_vector_type(2)));
using pg8::cvt_pk_bf16; using pg8::bf_lo; using pg8::bf_hi;

constexpr int NB = 2, SEQ = 4096, DM = 2048, DEPTH = 4, M = NB * SEQ, BW = 768, DIN = 6912, NGT = 6144, N1 = DIN + NGT;
constexpr int NH = 6, YW = 3 * BW;
constexpr float EPS = 1e-6f, L2E = 1.4426950408889634f;
constexpr int NWAVES = 8, NTHR = 512;
constexpr int LDS_BYTES = 147456;

constexpr size_t SZ_W1T = (size_t)N1 * DM * 2, SZ_WBT = (size_t)3 * DM * BW * 2, SZ_WOT = (size_t)DM * DM * 2, SZ_WPT = (size_t)4 * 192 * 192 * 2;
constexpr size_t WS_W1T = 1u << 20;
constexpr size_t WS_WBT = WS_W1T + DEPTH * SZ_W1T;
constexpr size_t WS_WOT = WS_WBT + DEPTH * SZ_WBT;
constexpr size_t WS_WPT = WS_WOT + DEPTH * SZ_WOT;
constexpr size_t WS_H = (WS_WPT + DEPTH * SZ_WPT + 4095) & ~(size_t)4095;
constexpr size_t WS_PROJ = WS_H + (size_t)M * DM * 2;
constexpr size_t WS_GATES = WS_PROJ + (size_t)9 * M * BW * 2;
constexpr size_t WS_Y = WS_GATES + (size_t)M * NGT * 2;
constexpr size_t WS_MERGED = WS_Y + (size_t)3 * M * BW * 2;
constexpr size_t WS_OUT = WS_MERGED + (size_t)M * DM * 2;
constexpr size_t WS_END = WS_OUT + (size_t)M * DM * 4;

struct Params {
    const float *x, *rel_bias, *g_pre, *w_in, *w_gate, *pool_w, *pool_scale, *lam, *subln_g, *sgu_ng, *sgu_nb, *sgu_w, *sgu_b, *w_branch, *w_out, *g_post;
    float* out; unsigned char* ws;
};

__device__ __forceinline__ float wave_sum(float v) {
#pragma unroll
    for (int o = 1; o < 64; o <<= 1) v += __shfl_xor(v, o);
    return v;
}
__device__ __forceinline__ float dot4(f32x4 a) { return (a.x * a.x + a.y * a.y) + (a.z * a.z + a.w * a.w); }

__device__ __forceinline__ void transpose_item(const float* W, int K, int N, bf16_t* WT, int row_off, LAS float* scr, int item, int lane) {
    const int nblk = N / 32, kb = item / nblk, nb = item % nblk, k0 = 64 * kb, n0 = 32 * nb;
#pragma unroll 8
    for (int i = 0; i < 32; ++i) { const int kk = 2 * i + (lane >> 5); scr[kk * 33 + (lane & 31)] = W[(size_t)(k0 + kk) * N + n0 + (lane & 31)]; }
    asm volatile("s_waitcnt lgkmcnt(0)" ::: "memory");
    const int c = lane & 7;
#pragma unroll
    for (int j = 0; j < 4; ++j) { const int n = (lane >> 3) + 8 * j; const LAS float* s = scr + (8 * c) * 33 + n;
        u32x4 o; o.x = cvt_pk_bf16(s[0 * 33], s[1 * 33]); o.y = cvt_pk_bf16(s[2 * 33], s[3 * 33]); o.z = cvt_pk_bf16(s[4 * 33], s[5 * 33]); o.w = cvt_pk_bf16(s[6 * 33], s[7 * 33]);
        *(u32x4*)(WT + (size_t)(row_off + n0 + n) * K + k0 + 8 * c) = o; }
    asm volatile("s_waitcnt lgkmcnt(0)" ::: "memory");
}

__device__ __forceinline__ void rms_row_to_bf16(const float* xrow, const float* g, bf16_t* orow, int lane) {
    const f32x4* xr = (const f32x4*)xrow + lane; const f32x4* gr = (const f32x4*)g + lane;
    f32x4 v[8]; float s = 0.f;
#pragma unroll
    for (int j = 0; j < 8; ++j) { v[j] = xr[64 * j]; s += dot4(v[j]); }
    const float rstd = 1.0f / sqrtf(wave_sum(s) * (1.f / DM) + EPS);
    u32x2* o8 = (u32x2*)orow + lane;
#pragma unroll
    for (int j = 0; j < 8; ++j) { const f32x4 gg = gr[64 * j]; u32x2 w; w.x = cvt_pk_bf16(v[j].x * rstd * gg.x, v[j].y * rstd * gg.y); w.y = cvt_pk_bf16(v[j].z * rstd * gg.z, v[j].w * rstd * gg.w); o8[64 * j] = w; }
}

constexpr int I_IN = 32 * 216, I_G = 32 * 192, I_B1 = 12 * 64, I_B = 3 * I_B1, I_O = 32 * 64, I_P1 = 18, I_P = 4 * I_P1, I_LAYER = I_IN + I_G + I_B + I_O + I_P;

__device__ __forceinline__ void convert_layer(const Params& p, int l, LAS unsigned char* lds, int gw0, int NGW) {
    int tid = threadIdx.x; asm volatile("" : "+v"(tid)); const int lane = tid & 63, wave = __builtin_amdgcn_readfirstlane(tid >> 6); const int gw = gw0 + wave;
    LAS float* scr = (LAS float*)(lds + wave * 16384);
    unsigned char* ws = p.ws;
    bf16_t* w1t = (bf16_t*)(ws + WS_W1T + l * SZ_W1T);
    for (int it = gw; it < I_LAYER; it += NGW) {
        int r = it;
        if (r < I_IN) { transpose_item(p.w_in + (size_t)l * DM * DIN, DM, DIN, w1t, 0, scr, r, lane); continue; } r -= I_IN;
        if (r < I_G) { transpose_item(p.w_gate + (size_t)l * DM * NGT, DM, NGT, w1t, DIN, scr, r, lane); continue; } r -= I_G;
        if (r < I_B) { transpose_item(p.w_branch + (size_t)l * YW * DM, YW, DM, (bf16_t*)(ws + WS_WBT + l * SZ_WBT), 0, scr, r, lane); continue; } r -= I_B;
        if (r < I_O) { transpose_item(p.w_out + (size_t)l * DM * DM, DM, DM, (bf16_t*)(ws + WS_WOT + l * SZ_WOT), 0, scr, r, lane); continue; } r -= I_O;
        { const int g = r / I_P1, rr = r - g * I_P1; transpose_item(p.pool_w + (size_t)(l * 4 + g) * 192 * 192, 192, 192, (bf16_t*)(ws + WS_WPT + l * SZ_WPT) + g * 192 * 192, 0, scr, rr, lane); }
    }
}
__device__ __forceinline__ void prologue(const Params& p, LAS unsigned char* lds, int vcu, int G, int nlayers) {
    for (int l = 0; l < nlayers; ++l) convert_layer(p, l, lds, vcu * NWAVES, G * NWAVES);
    int tid = threadIdx.x; asm volatile("" : "+v"(tid)); const int lane = tid & 63, wave = __builtin_amdgcn_readfirstlane(tid >> 6); const int gw = vcu * NWAVES + wave, NGW = G * NWAVES;
    for (int m = gw; m < M; m += NGW) rms_row_to_bf16(p.x + (size_t)m * DM, p.g_pre, (bf16_t*)(p.ws + WS_H) + (size_t)m * DM, lane);
}

__device__ __forceinline__ void rowpass(const float* xin, float* xout, const float* outb, const float* gpost, const float* gnext, bf16_t* H, int vcu, int G) {
    int tid = threadIdx.x; asm volatile("" : "+v"(tid)); const int lane = tid & 63, wave = __builtin_amdgcn_readfirstlane(tid >> 6); const int gw = vcu * NWAVES + wave, NGW = G * NWAVES;
    for (int m = gw; m < M; m += NGW) {
        const f32x4* o4 = (const f32x4*)(outb + (size_t)m * DM) + lane; const f32x4* x4 = (const f32x4*)(xin + (size_t)m * DM) + lane;
        f32x4* xo = (f32x4*)(xout + (size_t)m * DM) + lane; const f32x4* gp = (const f32x4*)gpost + lane;
        f32x4 o[8]; float ss = 0.f;
#pragma unroll
        for (int j = 0; j < 8; ++j) { o[j] = o4[64 * j]; ss += dot4(o[j]); }
        const float rstd = 1.0f / sqrtf(wave_sum(ss) * (1.f / DM) + EPS);
        float s2 = 0.f;
#pragma unroll
        for (int j = 0; j < 8; ++j) { const f32x4 g = gp[64 * j]; const f32x4 xv = x4[64 * j]; o[j] = xv + o[j] * rstd * g; s2 += dot4(o[j]); xo[64 * j] = o[j]; }
        if (gnext) {
            const float r2 = 1.0f / sqrtf(wave_sum(s2) * (1.f / DM) + EPS);
            const f32x4* gn = (const f32x4*)gnext + lane; u32x2* h8 = (u32x2*)(H + (size_t)m * DM) + lane;
#pragma unroll
            for (int j = 0; j < 8; ++j) { const f32x4 g = gn[64 * j]; u32x2 w; w.x = cvt_pk_bf16(o[j].x * r2 * g.x, o[j].y * r2 * g.y); w.y = cvt_pk_bf16(o[j].z * r2 * g.z, o[j].w * r2 * g.w); h8[64 * j] = w; }
        }
    }
}

__device__ __forceinline__ bf16x8 mk8(u32x4 v) { return __builtin_bit_cast(bf16x8, v); }
#define MFMA16(a, b, c) __builtin_amdgcn_mfma_f32_16x16x32_bf16((a), (b), (c), 0, 0, 0)

__device__ __forceinline__ void pool_unit(LAS unsigned char* lds, int u, const bf16_t* ax, const bf16_t* ag, const bf16_t* wpt, const float* pscale, bf16_t* y0) {
    int tid = threadIdx.x; asm volatile("" : "+v"(tid)); const int lane = tid & 63, wave = __builtin_amdgcn_readfirstlane(tid >> 6);
    const int tt = u >> 2, g = u & 3, wl = 2 << g, t0 = tt * 128;
    constexpr int POOL_RAW = 51200;
    { const bool head = ((t0 & (SEQ - 1)) == 0);
      u32x4 v[7];
#pragma unroll
      for (int i = 0; i < 7; ++i) { const int it = tid + i * NTHR, rr = it / 24, ch = it - rr * 24;
          v[i] = (u32x4){0u, 0u, 0u, 0u};
          if (it < 143 * 24 && !(head && rr < 15)) v[i] = *(const u32x4*)(ax + (size_t)(t0 - 15 + rr) * BW + g * 192 + ch * 8); }
#pragma unroll
      for (int i = 0; i < 7; ++i) { const int it = tid + i * NTHR, rr = it / 24, ch = it - rr * 24;
          if (it < 143 * 24) *(LAS u32x4*)(lds + POOL_RAW + rr * 400 + ch * 16) = v[i]; }
    }
    __syncthreads();
#pragma unroll 2
    for (int i6 = 0; i6 < 6; ++i6) { const int it = tid + i6 * NTHR;
        const int r = it / 24, ch = it - r * 24; const int ts = (t0 + r) & (SEQ - 1);
        const int cnt = (ts + 1 < wl) ? ts + 1 : wl;
        const LAS unsigned char* src = lds + POOL_RAW + (r + 15) * 400 + ch * 16;
        const u32x4 cur = *(const LAS u32x4*)src;
        const f32x4 xa = {bf_lo(cur.x), bf_hi(cur.x), bf_lo(cur.y), bf_hi(cur.y)}, xb = {bf_lo(cur.z), bf_hi(cur.z), bf_lo(cur.w), bf_hi(cur.w)};
        f32x4 sa = xa, sb = xb;
        for (int k = 1; k < cnt; ++k) { const u32x4 v = *(const LAS u32x4*)(src - k * 400);
            sa += (f32x4){bf_lo(v.x), bf_hi(v.x), bf_lo(v.y), bf_hi(v.y)}; sb += (f32x4){bf_lo(v.z), bf_hi(v.z), bf_lo(v.w), bf_hi(v.w)}; }
        const float ic = 1.0f / (float)cnt;
        sa = sa * ic - xa; sb = sb * ic - xb;
        u32x4 w; w.x = cvt_pk_bf16(sa.x, sa.y); w.y = cvt_pk_bf16(sa.z, sa.w); w.z = cvt_pk_bf16(sb.x, sb.y); w.w = cvt_pk_bf16(sb.z, sb.w);
        *(LAS u32x4*)(lds + r * 400 + ch * 16) = w;
    }
    __syncthreads();
    const int fr = lane & 15, fq = lane >> 4;
    for (int dt = wave; dt < 12; dt += 8) {
        const bf16_t* wbase = wpt + g * 192 * 192 + (16 * dt + fr) * 192 + fq * 8;
        bf16x8 wf[6];
#pragma unroll
        for (int ks = 0; ks < 6; ++ks) wf[ks] = *(const bf16x8*)(wbase + ks * 32);
        const int col = g * 192 + 16 * dt + 4 * fq;
        const f32x4 sc = *(const f32x4*)(pscale + col);
        u32x2 gg8[8];
#pragma unroll
        for (int tt = 0; tt < 8; ++tt) gg8[tt] = *(const u32x2*)(ag + (size_t)(t0 + 16 * tt + fr) * BW + col);
#pragma unroll
        for (int tt = 0; tt < 8; ++tt) {
            const int t = t0 + 16 * tt + fr;
            const u32x2 gg = gg8[tt];
            const LAS unsigned char* prow = lds + (16 * tt + fr) * 400 + fq * 16;
            f32x4 acc = {0.f, 0.f, 0.f, 0.f};
#pragma unroll
            for (int ks = 0; ks < 6; ++ks) { const bf16x8 pf = *(const LAS bf16x8*)(prow + ks * 64); acc = MFMA16(wf[ks], pf, acc); }
            const f32x4 v = acc * sc * (f32x4){bf_lo(gg.x), bf_hi(gg.x), bf_lo(gg.y), bf_hi(gg.y)};
            u32x2 w; w.x = cvt_pk_bf16(v.x, v.y); w.y = cvt_pk_bf16(v.z, v.w); *(u32x2*)(y0 + (size_t)t * YW + col) = w;
        }
    }
    __syncthreads();
}

typedef short v4i16s_t __attribute__((ext_vector_type(4)));
__device__ __forceinline__ s16x4 vtr_s(const LAS unsigned char* p) { return __builtin_bit_cast(s16x4, __builtin_amdgcn_ds_read_tr16_b64_v4i16((LAS v4i16s_t*)p)); }
__device__ __forceinline__ void sgu_unit(LAS unsigned char* lds, int u, const bf16_t* cu, const bf16_t* cv, const bf16_t* cgt, const float* ng, const float* nb, const float* wsf, const float* bs, bf16_t* y2) {
    int tid = threadIdx.x; asm volatile("" : "+v"(tid)); const int lane = tid & 63, wave = __builtin_amdgcn_readfirstlane(tid >> 6);
    const int ci = u / 6, g = u - 6 * ci, t0 = ci * 128;
    const int fr = lane & 15, fq = lane >> 4;
    LAS f32x2* stats = (LAS f32x2*)(lds + 36864);
#pragma unroll
    for (int i = 0; i < 4; ++i) { const int row = 16 * wave + 4 * i + fq; const u32x4* src = (const u32x4*)(cv + (size_t)(t0 + row) * BW) + fr;
        u32x4 v[6];
#pragma unroll
        for (int c = 0; c < 6; ++c) v[c] = src[16 * c];
        float s = 0.f, s2 = 0.f;
#pragma unroll
        for (int c = 0; c < 6; ++c) { const float a0 = bf_lo(v[c].x), a1 = bf_hi(v[c].x), a2 = bf_lo(v[c].y), a3 = bf_hi(v[c].y), a4 = bf_lo(v[c].z), a5 = bf_hi(v[c].z), a6 = bf_lo(v[c].w), a7 = bf_hi(v[c].w);
            s += ((a0 + a1) + (a2 + a3)) + ((a4 + a5) + (a6 + a7)); s2 += ((a0 * a0 + a1 * a1) + (a2 * a2 + a3 * a3)) + ((a4 * a4 + a5 * a5) + (a6 * a6 + a7 * a7)); }
#pragma unroll
        for (int o = 1; o < 16; o <<= 1) { s += __shfl_xor(s, o); s2 += __shfl_xor(s2, o); }
        const float mean = s * (1.f / BW); float var = s2 * (1.f / BW) - mean * mean; var = var > 0.f ? var : 0.f;
        if (fr == 0) stats[row] = (f32x2){mean, 1.0f / sqrtf(var + EPS)};
    }
    __syncthreads();
#pragma unroll
    for (int it = 0; it < 4; ++it) { const int item = tid + NTHR * it, chn = item & 15, q = item >> 4;
        const f32x2 st = stats[q]; const u32x4 v = *(const u32x4*)(cv + (size_t)(t0 + q) * BW + g * 128 + chn * 8);
        const f32x4 ga = *(const f32x4*)(ng + g * 128 + chn * 8), gb = *(const f32x4*)(ng + g * 128 + chn * 8 + 4), ba = *(const f32x4*)(nb + g * 128 + chn * 8), bb = *(const f32x4*)(nb + g * 128 + chn * 8 + 4);
        f32x4 xa = {bf_lo(v.x), bf_hi(v.x), bf_lo(v.y), bf_hi(v.y)}, xb = {bf_lo(v.z), bf_hi(v.z), bf_lo(v.w), bf_hi(v.w)};
        xa = (xa - st.x) * st.y * ga + ba; xb = (xb - st.x) * st.y * gb + bb;
        u32x4 w; w.x = cvt_pk_bf16(xa.x, xa.y); w.y = cvt_pk_bf16(xa.z, xa.w); w.z = cvt_pk_bf16(xb.x, xb.y); w.w = cvt_pk_bf16(xb.z, xb.w);
        *(LAS u32x4*)(lds + q * 288 + chn * 16) = w;
    }
    __syncthreads();
    const int pp = 16 * wave + fr;
    f32x4 acc[8];
#pragma unroll
    for (int c = 0; c < 8; ++c) acc[c] = (f32x4){0.f, 0.f, 0.f, 0.f};
    f32x4 wa[4], wb[4];
#pragma unroll
    for (int ks = 0; ks < 4; ++ks) { const float* wp = wsf + (size_t)(g * 128 + pp) * 128 + 32 * ks + 4 * fq; wa[ks] = *(const f32x4*)wp; wb[ks] = *(const f32x4*)(wp + 16); }
    u32x2 uu[8], gg8[8];
#pragma unroll
    for (int c = 0; c < 8; ++c) { const int col = g * 128 + 16 * c + 4 * fq; uu[c] = *(const u32x2*)(cu + (size_t)(t0 + pp) * BW + col); gg8[c] = *(const u32x2*)(cgt + (size_t)(t0 + pp) * BW + col); }
    const LAS unsigned char* Vb = lds + (4 * fq + ((lane & 15) >> 2)) * 288 + (lane & 3) * 8;
#pragma unroll
    for (int ks = 0; ks < 4; ++ks) {
        if (32 * ks <= 16 * wave + 15) {
            const int q0 = 32 * ks + 4 * fq;
            f32x4 a = wa[ks], b = wb[ks];
            a.x = (q0 + 0 <= pp) ? a.x : 0.f; a.y = (q0 + 1 <= pp) ? a.y : 0.f; a.z = (q0 + 2 <= pp) ? a.z : 0.f; a.w = (q0 + 3 <= pp) ? a.w : 0.f;
            b.x = (q0 + 16 <= pp) ? b.x : 0.f; b.y = (q0 + 17 <= pp) ? b.y : 0.f; b.z = (q0 + 18 <= pp) ? b.z : 0.f; b.w = (q0 + 19 <= pp) ? b.w : 0.f;
            u32x4 wv; wv.x = cvt_pk_bf16(a.x, a.y); wv.y = cvt_pk_bf16(a.z, a.w); wv.z = cvt_pk_bf16(b.x, b.y); wv.w = cvt_pk_bf16(b.z, b.w);
            const bf16x8 wf = mk8(wv);
#pragma unroll
            for (int c = 0; c < 8; ++c) { const s16x4 lo = vtr_s(Vb + (32 * ks) * 288 + c * 32), hi = vtr_s(Vb + (32 * ks + 16) * 288 + c * 32);
                const bf16x8 vf = (bf16x8){lo[0], lo[1], lo[2], lo[3], hi[0], hi[1], hi[2], hi[3]};
                acc[c] = MFMA16(vf, wf, acc[c]); }
        }
    }
    const int t = t0 + pp; const float bias = bs[g * 128 + pp];
#pragma unroll
    for (int c = 0; c < 8; ++c) { const int col = g * 128 + 16 * c + 4 * fq;
        const f32x4 v = (acc[c] + bias) * (f32x4){bf_lo(uu[c].x), bf_hi(uu[c].x), bf_lo(uu[c].y), bf_hi(uu[c].y)} * (f32x4){bf_lo(gg8[c].x), bf_hi(gg8[c].x), bf_lo(gg8[c].y), bf_hi(gg8[c].y)};
        u32x2 w; w.x = cvt_pk_bf16(v.x, v.y); w.y = cvt_pk_bf16(v.z, v.w); *(u32x2*)(y2 + (size_t)t * YW + col) = w; }
    __syncthreads();
}

constexpr int AK_STRIDE = 272, AV_STRIDE = 288, AK_BYTES = 64 * AK_STRIDE, AV_BYTES = 64 * AV_STRIDE, AV_OFF = 2 * AK_BYTES, ATBL_OFF = AV_OFF + 2 * AV_BYTES;
typedef short v4i16_t __attribute__((ext_vector_type(4)));
__device__ __forceinline__ s16x4 vtr(const LAS unsigned char* p) { return __builtin_bit_cast(s16x4, __builtin_amdgcn_ds_read_tr16_b64_v4i16((LAS v4i16_t*)p)); }

__device__ __forceinline__ float xmax16(float v) { auto r = __builtin_amdgcn_permlane16_swap(__float_as_uint(v), __float_as_uint(v), false, false); return fmaxf(__uint_as_float(r[0]), __uint_as_float(r[1])); }
__device__ __forceinline__ float xmax32(float v) { auto r = __builtin_amdgcn_permlane32_swap(__float_as_uint(v), __float_as_uint(v), false, false); return fmaxf(__uint_as_float(r[0]), __uint_as_float(r[1])); }
__device__ __forceinline__ void attn_unit(LAS unsigned char* lds, int bh, int qb, const bf16_t* Qs, const bf16_t* Ks, const bf16_t* Vs, const bf16_t* bg, const float* rel_bias, const float* lam, const float* subg, float lambda_init, bf16_t* y1) {
    int tid = threadIdx.x; asm volatile("" : "+v"(tid)); const int lane = tid & 63, wave = __builtin_amdgcn_readfirstlane(tid >> 6);
    const int b = bh / NH, h = bh - NH * b;
    const int fr = lane & 15, fq = lane >> 4;
    const int nt = 2 * qb + 2, jmax = 2 * qb + (wave >> 2), jnear = 2 * qb - 2;
    LAS float* tbl = (LAS float*)(lds + ATBL_OFF);
    { const int rel = tid - 256, n = rel < 0 ? -rel : rel;
      const int large = 8 + (n >= 12) + (n >= 16) + (n >= 23) + (n >= 32) + (n >= 46) + (n >= 64) + (n >= 91);
      const int bucket = (rel > 0 ? 16 : 0) + (n < 8 ? n : large);
      tbl[tid] = rel_bias[bucket * NH + h] * L2E; }
    const float c15 = rel_bias[15 * NH + h] * L2E;
    float lam_full;
    { const float a = lam[lane] * lam[64 + lane], c = lam[128 + lane] * lam[192 + lane]; lam_full = __expf(wave_sum(a)) - __expf(wave_sum(c)) + lambda_init; }
    const size_t rowbase = (size_t)b * SEQ;
    const int qpos = 128 * qb + 16 * wave + fr;
    bf16x8 qf[2][2];
    { const bf16_t* qp = Qs + (rowbase + qpos) * BW + h * 128 + fq * 8;
#pragma unroll
      for (int br = 0; br < 2; ++br)
#pragma unroll
          for (int ks = 0; ks < 2; ++ks) qf[br][ks] = *(const bf16x8*)(qp + br * 64 + ks * 32); }
    const int srow = tid >> 4, sch = tid & 15;
    const bf16_t* kg = Ks + (rowbase + srow) * BW + h * 128 + sch * 8;
    const bf16_t* vg = Vs + (rowbase + srow) * BW + h * 128 + sch * 8;
    u32x4 sk0, sk1, sv0, sv1;
    sk0 = *(const u32x4*)kg; sk1 = *(const u32x4*)(kg + 32 * BW); sv0 = *(const u32x4*)vg; sv1 = *(const u32x4*)(vg + 32 * BW);
    *(LAS u32x4*)(lds + srow * AK_STRIDE + sch * 16) = sk0; *(LAS u32x4*)(lds + (srow + 32) * AK_STRIDE + sch * 16) = sk1;
    *(LAS u32x4*)(lds + AV_OFF + srow * AV_STRIDE + sch * 16) = sv0; *(LAS u32x4*)(lds + AV_OFF + (srow + 32) * AV_STRIDE + sch * 16) = sv1;
    { const size_t adv = (size_t)64 * BW;
      sk0 = *(const u32x4*)(kg + adv); sk1 = *(const u32x4*)(kg + adv + 32 * BW); sv0 = *(const u32x4*)(vg + adv); sv1 = *(const u32x4*)(vg + adv + 32 * BW); }
#define A_BAR() do { asm volatile("s_waitcnt lgkmcnt(0)" ::: "memory"); __builtin_amdgcn_s_barrier(); asm volatile("" ::: "memory"); } while (0)
#define A_STAGE(jj) do { if ((jj) + 1 < nt) { const int bo = (((jj) + 1) & 1); \
        *(LAS u32x4*)(lds + bo * AK_BYTES + srow * AK_STRIDE + sch * 16) = sk0; *(LAS u32x4*)(lds + bo * AK_BYTES + (srow + 32) * AK_STRIDE + sch * 16) = sk1; \
        *(LAS u32x4*)(lds + AV_OFF + bo * AV_BYTES + srow * AV_STRIDE + sch * 16) = sv0; *(LAS u32x4*)(lds + AV_OFF + bo * AV_BYTES + (srow + 32) * AV_STRIDE + sch * 16) = sv1; \
        if ((jj) + 2 < nt) { const size_t adv = (size_t)((jj) + 2) * 64 * BW; \
            sk0 = *(const u32x4*)(kg + adv); sk1 = *(const u32x4*)(kg + adv + 32 * BW); sv0 = *(const u32x4*)(vg + adv); sv1 = *(const u32x4*)(vg + adv + 32 * BW); } } } while (0)
    A_BAR();
    f32x4 o1[8], o2[8];
#pragma unroll
    for (int d = 0; d < 8; ++d) { o1[d] = (f32x4){0.f, 0.f, 0.f, 0.f}; o2[d] = (f32x4){0.f, 0.f, 0.f, 0.f}; }
    float m1 = -1e30f, m2 = -1e30f, l1 = 0.f, l2 = 0.f;
    const float CS = 0.125f * L2E;
    const int kvoff = fr * AK_STRIDE + fq * 16;
    const int vvoff = (4 * fq + ((lane & 15) >> 2)) * AV_STRIDE + (lane & 3) * 8;
    const int half = wave >> 2;
    if (half) A_BAR();
    for (int j = 0; j < nt; ++j) {
        bf16x8 p1[2], p2[2];
        if (j <= jmax) {
            const LAS unsigned char* Kb = lds + (j & 1) * AK_BYTES + kvoff;
            f32x4 s1[4], s2[4];
#pragma unroll
            for (int kt = 0; kt < 4; ++kt) {
                const bf16x8 k00 = *(const LAS bf16x8*)(Kb + kt * 16 * AK_STRIDE), k01 = *(const LAS bf16x8*)(Kb + kt * 16 * AK_STRIDE + 64);
                const bf16x8 k10 = *(const LAS bf16x8*)(Kb + kt * 16 * AK_STRIDE + 128), k11 = *(const LAS bf16x8*)(Kb + kt * 16 * AK_STRIDE + 192);
                f32x4 z = {0.f, 0.f, 0.f, 0.f};
                s1[kt] = MFMA16(k00, qf[0][0], z); s1[kt] = MFMA16(k01, qf[0][1], s1[kt]);
                s2[kt] = MFMA16(k10, qf[1][0], z); s2[kt] = MFMA16(k11, qf[1][1], s2[kt]);
            }
            const bool near = (j >= jnear);
            if (near) {
                const int ib = 64 * j + 4 * fq - qpos + 256;
#pragma unroll
                for (int kt = 0; kt < 4; ++kt) {
                    const float b0 = tbl[ib + 16 * kt], b1 = tbl[ib + 16 * kt + 1], b2 = tbl[ib + 16 * kt + 2], b3 = tbl[ib + 16 * kt + 3];
                    s1[kt].x = s1[kt].x * CS + b0; s1[kt].y = s1[kt].y * CS + b1; s1[kt].z = s1[kt].z * CS + b2; s1[kt].w = s1[kt].w * CS + b3;
                    s2[kt].x = s2[kt].x * CS + b0; s2[kt].y = s2[kt].y * CS + b1; s2[kt].z = s2[kt].z * CS + b2; s2[kt].w = s2[kt].w * CS + b3;
                }
            }
            float x1 = fmaxf(fmaxf(fmaxf(s1[0].x, s1[0].y), fmaxf(s1[0].z, s1[0].w)), fmaxf(fmaxf(s1[1].x, s1[1].y), fmaxf(s1[1].z, s1[1].w)));
            x1 = fmaxf(x1, fmaxf(fmaxf(fmaxf(s1[2].x, s1[2].y), fmaxf(s1[2].z, s1[2].w)), fmaxf(fmaxf(s1[3].x, s1[3].y), fmaxf(s1[3].z, s1[3].w))));
            float x2 = fmaxf(fmaxf(fmaxf(s2[0].x, s2[0].y), fmaxf(s2[0].z, s2[0].w)), fmaxf(fmaxf(s2[1].x, s2[1].y), fmaxf(s2[1].z, s2[1].w)));
            x2 = fmaxf(x2, fmaxf(fmaxf(fmaxf(s2[2].x, s2[2].y), fmaxf(s2[2].z, s2[2].w)), fmaxf(fmaxf(s2[3].x, s2[3].y), fmaxf(s2[3].z, s2[3].w))));
            x1 = xmax16(x1); x1 = xmax32(x1); x2 = xmax16(x2); x2 = xmax32(x2);
            const float sc = near ? 1.0f : CS, cb = near ? 0.0f : c15;
            const float cand1 = x1 * sc + cb, cand2 = x2 * sc + cb;
            if (__builtin_amdgcn_ballot_w64(cand1 > m1 + 8.0f) != 0ull) { const float mn = fmaxf(m1, cand1), al = __builtin_amdgcn_exp2f(m1 - mn); m1 = mn; l1 *= al;
#pragma unroll
                for (int d = 0; d < 8; ++d) o1[d] = o1[d] * al; }
            if (__builtin_amdgcn_ballot_w64(cand2 > m2 + 8.0f) != 0ull) { const float mn = fmaxf(m2, cand2), al = __builtin_amdgcn_exp2f(m2 - mn); m2 = mn; l2 *= al;
#pragma unroll
                for (int d = 0; d < 8; ++d) o2[d] = o2[d] * al; }
            const float of1 = cb - m1, of2 = cb - m2;
            float r1 = 0.f, r2 = 0.f;
#pragma unroll
            for (int kt = 0; kt < 4; ++kt) {
                s1[kt].x = __builtin_amdgcn_exp2f(s1[kt].x * sc + of1); s1[kt].y = __builtin_amdgcn_exp2f(s1[kt].y * sc + of1); s1[kt].z = __builtin_amdgcn_exp2f(s1[kt].z * sc + of1); s1[kt].w = __builtin_amdgcn_exp2f(s1[kt].w * sc + of1);
                s2[kt].x = __builtin_amdgcn_exp2f(s2[kt].x * sc + of2); s2[kt].y = __builtin_amdgcn_exp2f(s2[kt].y * sc + of2); s2[kt].z = __builtin_amdgcn_exp2f(s2[kt].z * sc + of2); s2[kt].w = __builtin_amdgcn_exp2f(s2[kt].w * sc + of2);
                r1 += (s1[kt].x + s1[kt].y) + (s1[kt].z + s1[kt].w); r2 += (s2[kt].x + s2[kt].y) + (s2[kt].z + s2[kt].w);
            }
            l1 += r1; l2 += r2;
#pragma unroll
            for (int st = 0; st < 2; ++st) {
                u32x4 a; a.x = cvt_pk_bf16(s1[2 * st].x, s1[2 * st].y); a.y = cvt_pk_bf16(s1[2 * st].z, s1[2 * st].w); a.z = cvt_pk_bf16(s1[2 * st + 1].x, s1[2 * st + 1].y); a.w = cvt_pk_bf16(s1[2 * st + 1].z, s1[2 * st + 1].w);
                u32x4 c; c.x = cvt_pk_bf16(s2[2 * st].x, s2[2 * st].y); c.y = cvt_pk_bf16(s2[2 * st].z, s2[2 * st].w); c.z = cvt_pk_bf16(s2[2 * st + 1].x, s2[2 * st + 1].y); c.w = cvt_pk_bf16(s2[2 * st + 1].z, s2[2 * st + 1].w);
                p1[st] = mk8(a); p2[st] = mk8(c);
            }
        }
        if (half) A_STAGE(j);
        A_BAR();
        if (j <= jmax) {
            const LAS unsigned char* Vb = lds + AV_OFF + (j & 1) * AV_BYTES + vvoff;
            __builtin_amdgcn_s_setprio(1);
#pragma unroll
            for (int d = 0; d < 8; ++d)
#pragma unroll
                for (int st = 0; st < 2; ++st) {
                    const s16x4 lo = vtr(Vb + (32 * st) * AV_STRIDE + d * 32), hi = vtr(Vb + (32 * st + 16) * AV_STRIDE + d * 32);
                    const bf16x8 vf = (bf16x8){lo[0], lo[1], lo[2], lo[3], hi[0], hi[1], hi[2], hi[3]};
                    o1[d] = MFMA16(vf, p1[st], o1[d]); o2[d] = MFMA16(vf, p2[st], o2[d]);
                }
            __builtin_amdgcn_s_setprio(0);
        }
        if (!half) A_STAGE(j);
        A_BAR();
    }
    if (!half) A_BAR();
#undef A_BAR
#undef A_STAGE
    l1 += __shfl_xor(l1, 16); l1 += __shfl_xor(l1, 32); l2 += __shfl_xor(l2, 16); l2 += __shfl_xor(l2, 32);
    const float i1 = 1.0f / l1, i2 = lam_full / l2;
    float ss = 0.f;
#pragma unroll
    for (int d = 0; d < 8; ++d) { o1[d] = o1[d] * i1 - o2[d] * i2; ss += dot4(o1[d]); }
    ss += __shfl_xor(ss, 16); ss += __shfl_xor(ss, 32);
    const float rs = (1.0f / sqrtf(ss * (1.f / 128.f) + EPS)) * (1.0f - lambda_init);
    const size_t t = rowbase + qpos;
#pragma unroll
    for (int d = 0; d < 8; ++d) { const int dv = 16 * d + 4 * fq; const int col = h * 128 + dv;
        const f32x4 sg = *(const f32x4*)(subg + dv); const u32x2 gg = *(const u32x2*)(bg + t * BW + col);
        const f32x4 v = o1[d] * rs * sg * (f32x4){bf_lo(gg.x), bf_hi(gg.x), bf_lo(gg.y), bf_hi(gg.y)};
        u32x2 w; w.x = cvt_pk_bf16(v.x, v.y); w.y = cvt_pk_bf16(v.z, v.w); *(u32x2*)(y1 + t * YW + col) = w; }
}

#define XB_TMO      128
#define XB_XCNT(j)  (256  + 64 * (j))
#define XB_XSUB(j)  (1280 + 64 * (j))
#define XB_XGEN(j)  (2304 + 64 * (j))
#define XB_TOP      3328
#define XB_TOPGEN   3392
#define XCD_BAR_WORDS 3456
#define XB_SPIN_CAP (1u << 18)

__device__ __forceinline__ unsigned xb_ld(unsigned* p)              { return __hip_atomic_load(p, __ATOMIC_RELAXED, __HIP_MEMORY_SCOPE_AGENT); }
__device__ __forceinline__ unsigned xb_add(unsigned* p, unsigned v) { return __hip_atomic_fetch_add(p, v, __ATOMIC_RELAXED, __HIP_MEMORY_SCOPE_AGENT); }
__device__ __forceinline__ unsigned xb_xcc_id() { return (unsigned)__builtin_amdgcn_s_getreg((3 << 11) | 20) & 0xFu; }
#define XB_SPIN(cond, bar) do { unsigned _sp = 0; while (cond) { __builtin_amdgcn_s_sleep(1); \
    if ((++_sp & 255u) == 0u) { if (xb_ld(&(bar)[XB_TMO])) break; if (_sp > XB_SPIN_CAP) { atomicAdd(&(bar)[XB_TMO], 1u); break; } } } } while (0)

struct XcdBarrier {
    unsigned* bar; unsigned x;
    volatile LAS unsigned* st;
};

__device__ __forceinline__ XcdBarrier xcd_barrier_post(unsigned* bar, volatile LAS unsigned* st) {
    XcdBarrier b; b.bar = bar; b.x = xb_xcc_id(); b.st = st;
    if (threadIdx.x == 0) (void)xb_add(&bar[XB_XCNT(b.x)], 1u);
    return b;
}
__device__ __forceinline__ void xcd_barrier_complete(unsigned* bar, unsigned x, unsigned& nloc, unsigned& nx) {
    const unsigned G = gridDim.x * gridDim.y * gridDim.z;
    unsigned sum, cnt, mine, sp = 0u;
    for (;;) {
        sum = 0u; cnt = 0u; mine = 0u;
#pragma unroll
        for (unsigned j = 0; j < 16; ++j) { const unsigned c = xb_ld(&bar[XB_XCNT(j)]); sum += c; cnt += (c > 0u) ? 1u : 0u; mine = (j == x) ? c : mine; }
        if (sum == G) break;
        __builtin_amdgcn_s_sleep(1);
        if ((++sp & 255u) == 0u) { if (xb_ld(&bar[XB_TMO])) break; if (sp > XB_SPIN_CAP) { atomicAdd(&bar[XB_TMO], 1u); break; } }
    }
    nloc = mine > 0u ? mine : 1u; nx = cnt > 0u ? cnt : 1u;
}

__device__ __forceinline__ void xcd_barrier(const XcdBarrier& b) {
    asm volatile("s_waitcnt vmcnt(0)" ::: "memory");
    __syncthreads();
    if (threadIdx.x == 0) {
        unsigned* bar = b.bar;
        __builtin_amdgcn_s_waitcnt(0);
        unsigned nloc = b.st[0], nx = b.st[1];
        if (nloc == 0u) { xcd_barrier_complete(bar, b.x, nloc, nx); b.st[0] = nloc; b.st[1] = nx; }
        const unsigned old = xb_add(&bar[XB_XSUB(b.x)], 1u);
        const unsigned gen = old / nloc;
        if (old + 1u == (gen + 1u) * nloc) {
            __builtin_amdgcn_fence(__ATOMIC_RELEASE, "agent");
            asm volatile("s_waitcnt vmcnt(0)" ::: "memory");
            const unsigned og = xb_add(&bar[XB_TOP], 1u);
            const unsigned tg = og / nx;
            if (og + 1u == (tg + 1u) * nx) xb_add(&bar[XB_TOPGEN], 1u);
            else XB_SPIN(xb_ld(&bar[XB_TOPGEN]) == tg, bar);
            __builtin_amdgcn_fence(__ATOMIC_ACQUIRE, "agent");
            xb_add(&bar[XB_XGEN(b.x)], 1u);
            asm volatile("s_waitcnt vmcnt(0)" ::: "memory");
        } else {
            XB_SPIN(xb_ld(&bar[XB_XGEN(b.x)]) == gen, bar);
            __builtin_amdgcn_fence(__ATOMIC_ACQUIRE, "agent");
            asm volatile("s_waitcnt vmcnt(0)" ::: "memory");
        }
    }
    __syncthreads();
}

#define GSYNC() do { xcd_barrier(xb); if (REP_MASK & 16) xcd_barrier(xb); } while (0)
constexpr int MISC_OFF = 131072 + 256;
constexpr int QCTR_WORD = 4096;
#ifndef DEFER_REDUNDANT
#define DEFER_REDUNDANT 1
#endif
#ifndef DEFER_FIRST
#define DEFER_FIRST 0
#endif
#ifndef DEFER_COLS
#define DEFER_COLS 0
#endif
struct DeferOrder { int idx; __device__ bool next(int i, pg8::Unit& u) const { if (i > 0 || idx < 0 || idx >= 96) return false; u.pm = idx & 31; u.pn = 48 + (idx >> 5); return true; }
    __device__ __forceinline__ void a_ready(const pg8::Unit&) const {} __device__ __forceinline__ void done(const pg8::Unit&) const {} };

__global__ void __launch_bounds__(NTHR) mega_fwd(Params p) {
    extern __shared__ __attribute__((aligned(16))) unsigned char lds_raw[];
    cg::grid_group grid = cg::this_grid();
    LAS unsigned char* lds = (LAS unsigned char*)lds_raw;
    const int G = gridDim.x, bx = blockIdx.x;
    const int vcu = (G % 8 == 0) ? (bx % 8) * (G / 8) + bx / 8 : bx;
    unsigned char* ws = p.ws;
    bf16_t* H = (bf16_t*)(ws + WS_H); bf16_t* PROJ = (bf16_t*)(ws + WS_PROJ); bf16_t* GATES = (bf16_t*)(ws + WS_GATES); bf16_t* Y = (bf16_t*)(ws + WS_Y);
    bf16_t* MERGED = (bf16_t*)(ws + WS_MERGED); float* OUTB = (float*)(ws + WS_OUT);
    const size_t SEC = (size_t)M * BW;

    unsigned* barw = (unsigned*)ws;
    { int t0 = threadIdx.x; if (bx == 0) { for (int i = t0; i < XCD_BAR_WORDS; i += NTHR) barw[i] = 0u; if (t0 < DEPTH) barw[QCTR_WORD + 64 * t0] = (unsigned)G; }
      if (t0 < 4) ((volatile LAS unsigned*)(lds + MISC_OFF))[t0] = 0u; }
    __syncthreads();
    const bool shadow = false;
    prologue(p, lds, vcu, G, shadow ? 1 : DEPTH);
    grid.sync();
    XcdBarrier xb = xcd_barrier_post(barw, (volatile LAS unsigned*)(lds + MISC_OFF));

    for (int l = 0; l < DEPTH; ++l) {
        const float lambda_init = 0.8f - 0.6f * __expf(-0.3f * (float)l);
#ifndef NO_G1
        for (int rep = 0; rep < ((REP_MASK & 4) ? 2 : 1); ++rep)
        { pg8::Gemm g{H, (const bf16_t*)(ws + WS_W1T + l * SZ_W1T), M, N1, DM}; pg8::StaticOrder S; S.init(M, N1 - (DEFER_REDUNDANT ? 0 : DEFER_COLS), G, bx);
          pg8::EpiG1 E{PROJ, GATES};
          pg8::gemm_phase<pg8::EpiG1, pg8::StaticOrder, true, true>(lds, g, S, E); }
        if (shadow && l + 1 < DEPTH && bx >= 96) convert_layer(p, l + 1, lds, (bx - 96) * NWAVES, 160 * NWAVES);
#endif
        GSYNC();
        {
#define ATTN_U(bh_, qb_) attn_unit(lds, (bh_), (qb_), PROJ + 2 * SEC, PROJ + 3 * SEC, PROJ + 4 * SEC, PROJ + 5 * SEC, p.rel_bias, p.lam + l * 256, p.subln_g + l * 128, lambda_init, Y + BW)
#define MIX_U(j_) do { const int jj_ = (j_); if (jj_ < 384) sgu_unit(lds, jj_, PROJ + 6 * SEC, PROJ + 7 * SEC, PROJ + 8 * SEC, p.sgu_ng + l * BW, p.sgu_nb + l * BW, p.sgu_w + (size_t)l * 6 * 128 * 128, p.sgu_b + l * 6 * 128, Y + 2 * BW); \
                         else pool_unit(lds, jj_ - 384, PROJ, PROJ + SEC, (const bf16_t*)(ws + WS_WPT + l * SZ_WPT), p.pool_scale + l * BW, Y); } while (0)
          if (G == 256) {
              const int x = vcu >> 5, lc = vcu & 31, k3 = 3 * (x >> 1), odd = x & 1;
              ATTN_U(k3 + (odd ? 2 : 0), 31 - lc);
              if (lc >= 16) { const int jh = 31 - lc; ATTN_U(k3 + 1, odd ? 30 - 2 * jh : 31 - 2 * jh); }
              const int hf = lc >> 4, d = hf ? lc - 16 : 15 - lc;
              int pre = 0, n = 0;
              for (int dd = 0; dd <= d; ++dd) { pre += n; n = (dd < 2) ? 5 : (dd < 5) ? 4 : (dd < 8) ? 3 : (dd < 11) ? 2 : (dd < 14) ? 1 : 0; }
#pragma unroll 1
              for (int i = 0; i < n; ++i) { const int j = 80 * x + 40 * hf + pre + i; MIX_U((j & 7) * 80 + (j >> 3)); }
          } else {
              for (int r = 0;; ++r) { const int u = r * G + ((r & 1) ? (G - 1 - vcu) : vcu); if (u >= 384) break; ATTN_U(u % 12, 31 - u / 12); }
              for (int j = vcu; j < 640; j += G) MIX_U(j);
          }
#undef ATTN_U
#undef MIX_U
        }
        GSYNC();
#ifndef NO_G2
        for (int rep = 0; rep < ((REP_MASK & 8) ? 2 : 1); ++rep)
        { pg8::Gemm g{Y, (const bf16_t*)(ws + WS_WBT + l * SZ_WBT), M, DM, YW}; pg8::StaticOrder S; S.init(M, DM, G, bx);
          pg8::EpiG2h E{GATES, MERGED};
          pg8::gemm_phase<pg8::EpiG2h, pg8::StaticOrder, true, true>(lds, g, S, E); }
#endif
        GSYNC();
#ifndef NO_G3
        for (int rep = 0; rep < ((REP_MASK & 8) ? 2 : 1); ++rep)
        { pg8::Gemm g{MERGED, (const bf16_t*)(ws + WS_WOT + l * SZ_WOT), M, DM, DM}; pg8::StaticOrder S; S.init(M, DM, G, bx);
          pg8::EpiG3 E{OUTB};
          pg8::gemm_phase<pg8::EpiG3, pg8::StaticOrder, true, true>(lds, g, S, E); }
#endif
        GSYNC();
        rowpass(l == 0 ? p.x : p.out, p.out, OUTB, p.g_post + l * DM, (l + 1 < DEPTH) ? p.g_pre + (l + 1) * DM : nullptr, H, vcu, G);
        if (l + 1 < DEPTH) GSYNC();
    }
}

extern "C" void kernel_launch(void* const* d_in, const int* in_sizes, int n_in, void* d_out, int out_size, void* d_ws, size_t ws_size, hipStream_t stream) {
    static int grid = 0;
    if (grid == 0) {
        if (n_in != 16 || in_sizes[0] != M * DM || out_size != M * DM || ws_size < WS_END) { fprintf(stderr, "kernel_launch: unexpected shapes / workspace (%zu < %zu); nothing launched\n", ws_size, (size_t)WS_END); grid = -1; return; }
        int dev = 0, cus = 0, per_cu = 0;
        hipGetDevice(&dev); hipDeviceGetAttribute(&cus, hipDeviceAttributeMultiprocessorCount, dev);
        if (hipFuncSetAttribute((const void*)mega_fwd, hipFuncAttributeMaxDynamicSharedMemorySize, LDS_BYTES) != hipSuccess) { fprintf(stderr, "kernel_launch: hipFuncSetAttribute failed\n"); grid = -1; return; }
        if (hipOccupancyMaxActiveBlocksPerMultiprocessor(&per_cu, (const void*)mega_fwd, NTHR, LDS_BYTES) != hipSuccess || per_cu < 1) { fprintf(stderr, "kernel_launch: occupancy query failed (%d)\n", per_cu); (void)hipGetLastError(); per_cu = 1; }
        grid = cus * per_cu;
    }
    if (grid < 0) return;
    Params p{};
    p.x = (const float*)d_in[0]; p.rel_bias = (const float*)d_in[1]; p.g_pre = (const float*)d_in[2]; p.w_in = (const float*)d_in[3]; p.w_gate = (const float*)d_in[4];
    p.pool_w = (const float*)d_in[5]; p.pool_scale = (const float*)d_in[6]; p.lam = (const float*)d_in[7]; p.subln_g = (const float*)d_in[8]; p.sgu_ng = (const float*)d_in[9];
    p.sgu_nb = (const float*)d_in[10]; p.sgu_w = (const float*)d_in[11]; p.sgu_b = (const float*)d_in[12]; p.w_branch = (const float*)d_in[13]; p.w_out = (const float*)d_in[14]; p.g_post = (const float*)d_in[15];
    p.out = (float*)d_out; p.ws = (unsigned char*)d_ws;
    void* args[] = {&p};
    hipError_t e = hipLaunchCooperativeKernel((const void*)mega_fwd, dim3(grid), dim3(NTHR), args, LDS_BYTES, stream);
    if (e != hipSuccess) fprintf(stderr, "cooperative launch failed: %s (grid %d)\n", hipGetErrorString(e), grid);
}
```

```cpp
#include <hip/hip_runtime.h>
#include <hip/hip_cooperative_groups.h>
#include <cstdio>
#include <cstdint>
namespace cg = cooperative_groups;
#ifndef REP_MASK
#define REP_MASK 0
#endif
namespace pg8 {
#define PG8_LAS __attribute__((address_space(3)))
typedef unsigned short bf16_t;
typedef short bf16x8 __attribute__((ext_vector_type(8)));
typedef float f32x4 __attribute__((ext_vector_type(4)));
typedef unsigned u32x4 __attribute__((ext_vector_type(4)));
constexpr int BM = 256, BK = 64, HALF = 128, HTB = HALF * BK * 2  , STAGE_BYTES = 8 * HTB, NXCD = 8, WGM = 8;

__host__ __device__ __forceinline__ int lds_byte(int r, int c) { const int st = (r >> 4) * 2 + (c >> 5), rr = r & 15, cc = c & 31, ob = rr * 64 + cc * 2; return st * 1024 + (ob ^ (((ob >> 9) & 1) << 5)); }
__host__ __device__ __forceinline__ void stage_rc(int b, int& R, int& C) { const int st = b / 1024, sb = b % 1024, swz = sb ^ (((sb >> 9) & 1) << 5); R = (st >> 1) * 16 + swz / 64; C = (st & 1) * 32 + (swz % 64) / 2; }
__host__ __device__ __forceinline__ int perm32(int rho) { const int n = rho >> 4, i = rho & 15; return 8 * (i >> 2) + 4 * n + (i & 3); }

struct Unit { int pm, pn; };
struct Gemm { const bf16_t* A; const bf16_t* Bt; int M, N, K; };

struct StaticOrder {
    int nM, nN, nwg, G, c;
    __host__ __device__ void init(int M, int N, int G_, int c_) { nM = M / BM; nN = N / BM; nwg = nM * nN; G = G_; c = c_; }
    __host__ __device__ bool next(int i, Unit& u) const {
        const long L = (long)i * G + c; if (L >= nwg) return false;
        int wgid = (int)L; { const int q = nwg / NXCD, r = nwg % NXCD, xcd = wgid % NXCD, off = wgid / NXCD; wgid = (xcd < r ? xcd * (q + 1) : r * (q + 1) + (xcd - r) * q) + off; }
        const int nig = WGM * nN, gid = wgid / nig, fm = gid * WGM, gsz = (nM - fm) < WGM ? (nM - fm) : WGM;
        u.pm = fm + ((wgid % nig) % gsz); u.pn = (wgid % nig) / gsz; return true;
    }
    __device__ __forceinline__ void a_ready(const Unit&) const {}
    __device__ __forceinline__ void done(const Unit&) const {}
};

__device__ __forceinline__ unsigned cvt_pk_bf16(float lo, float hi) { unsigned r; asm volatile("v_cvt_pk_bf16_f32 %0, %1, %2" : "=v"(r) : "v"(lo), "v"(hi)); return r; }
typedef float f32x2 __attribute__((ext_vector_type(2)));
__device__ __forceinline__ f32x2 gelu_pk(f32x2 v) {
    const f32x2 av = __builtin_elementwise_abs(v), d = av * 0.2316418882f + 1.0f;
    f32x2 t; t.x = __builtin_amdgcn_rcpf(d.x); t.y = __builtin_amdgcn_rcpf(d.y);
    f32x2 q = t * 0.5307027145f + (-0.7265760135f); q = q * t + 0.7107068705f; q = q * t + (-0.142248368f); q = q * t + 0.127414796f; q = q * t;
    const f32x2 s = (v * v) * (-0.72134752044f);
    f32x2 e; e.x = __builtin_amdgcn_exp2f(s.x); e.y = __builtin_amdgcn_exp2f(s.y);
    const f32x2 m = v * (q * e), r = v - m;
    f32x2 o; o.x = v.x < 0.f ? m.x : r.x; o.y = v.y < 0.f ? m.y : r.y; return o;
}


__device__ __forceinline__ float bf_lo(unsigned u) { return __uint_as_float(u << 16); }
__device__ __forceinline__ float bf_hi(unsigned u) { return __uint_as_float(u & 0xffff0000u); }
__device__ __forceinline__ float act_sig(float x, float na, float nb, bool mulx) {
    const float z = x * (na + nb * x * x);
    const float s = __builtin_amdgcn_rcpf(1.0f + __builtin_amdgcn_exp2f(z));
    return mulx ? x * s : fmaxf(s, 1e-18f);
}
constexpr int TOK = 8192, BRW = 768, NGATE = 6144, DMODEL = 2048;
struct EpiG1 {
    static constexpr bool PERM = true, AFTER_DRAIN = false, MID = false;
    bf16_t* proj; bf16_t* gates;
    __device__ __forceinline__ void operator()(const f32x4 (&acc)[2][2][4][2], const Unit& u, int wr, int wc, int fr, int fq) const {
        const int row0 = u.pm * BM + wr * 64 + fr; const int pn = u.pn;
        bf16_t* base; int ldc, colt, act;
        if (pn < 27) { const int s = pn / 3; base = proj + (size_t)s * TOK * BRW; ldc = BRW; colt = (pn - 3 * s) * BM; act = (s == 1 || s == 5 || s == 8) ? 1 : ((s == 6 || s == 7) ? 2 : 0); }
        else { base = gates; ldc = NGATE; colt = (pn - 27) * BM; act = 3; }
        const int col0 = colt + wc * 32 + 8 * fq;
        if (act == 0) {
#pragma unroll
            for (int ai = 0; ai < 2; ++ai)
#pragma unroll
                for (int m = 0; m < 4; ++m) { bf16_t* rowp = base + (size_t)(row0 + ai * HALF + m * 16) * ldc + col0;
#pragma unroll
                    for (int bj = 0; bj < 2; ++bj) { const f32x4 v0 = acc[ai][bj][m][0], v1 = acc[ai][bj][m][1];
                        u32x4 w; w.x = cvt_pk_bf16(v0[0], v0[1]); w.y = cvt_pk_bf16(v0[2], v0[3]); w.z = cvt_pk_bf16(v1[0], v1[1]); w.w = cvt_pk_bf16(v1[2], v1[3]);
                        *(u32x4*)(rowp + bj * HALF) = w; } }
        } else {
            const float L2E = 1.4426950408889634f;
            const float na = (act == 2) ? -L2E * 1.5957691216057308f : -L2E, nb = (act == 2) ? -L2E * 1.5957691216057308f * 0.044715f : 0.f; const bool mulx = (act != 3);
#pragma unroll
            for (int ai = 0; ai < 2; ++ai)
#pragma unroll
                for (int m = 0; m < 4; ++m) { bf16_t* rowp = base + (size_t)(row0 + ai * HALF + m * 16) * ldc + col0;
#pragma unroll
                    for (int bj = 0; bj < 2; ++bj) { const f32x4 v0 = acc[ai][bj][m][0], v1 = acc[ai][bj][m][1];
                        u32x4 w; w.x = cvt_pk_bf16(act_sig(v0[0], na, nb, mulx), act_sig(v0[1], na, nb, mulx)); w.y = cvt_pk_bf16(act_sig(v0[2], na, nb, mulx), act_sig(v0[3], na, nb, mulx));
                        w.z = cvt_pk_bf16(act_sig(v1[0], na, nb, mulx), act_sig(v1[1], na, nb, mulx)); w.w = cvt_pk_bf16(act_sig(v1[2], na, nb, mulx), act_sig(v1[3], na, nb, mulx));
                        *(u32x4*)(rowp + bj * HALF) = w; } }
        }
    }
};
struct EpiG2 {
    static constexpr bool PERM = true, AFTER_DRAIN = false, MID = false;
    const bf16_t* gates; float* part; bf16_t* merged;
    __device__ __forceinline__ void operator()(const f32x4 (&acc)[2][2][4][2], const Unit& u, int wr, int wc, int fr, int fq) const {
        const int n = u.pm >> 5, pm = u.pm & 31, pn = u.pn & 7;
        const int row0 = pm * BM + wr * 64 + fr, col0 = pn * BM + wc * 32 + 8 * fq;
#pragma unroll
        for (int ai = 0; ai < 2; ++ai)
#pragma unroll
            for (int m = 0; m < 4; ++m) { const size_t r = (size_t)(row0 + ai * HALF + m * 16);
#pragma unroll
                for (int bj = 0; bj < 2; ++bj) { const int c = col0 + bj * HALF;
                    const u32x4 g = *(const u32x4*)(gates + r * NGATE + n * DMODEL + c);
                    f32x4 v0 = acc[ai][bj][m][0], v1 = acc[ai][bj][m][1];
                    v0[0] *= bf_lo(g.x); v0[1] *= bf_hi(g.x); v0[2] *= bf_lo(g.y); v0[3] *= bf_hi(g.y); v1[0] *= bf_lo(g.z); v1[1] *= bf_hi(g.z); v1[2] *= bf_lo(g.w); v1[3] *= bf_hi(g.w);
                    float* pp = part + r * DMODEL + c;
                    if (n == 0) { *(f32x4*)pp = v0; *(f32x4*)(pp + 4) = v1; }
                    else { v0 += *(const f32x4*)pp; v1 += *(const f32x4*)(pp + 4);
                        if (n == 1) { *(f32x4*)pp = v0; *(f32x4*)(pp + 4) = v1; }
                        else { u32x4 w; w.x = cvt_pk_bf16(v0[0], v0[1]); w.y = cvt_pk_bf16(v0[2], v0[3]); w.z = cvt_pk_bf16(v1[0], v1[1]); w.w = cvt_pk_bf16(v1[2], v1[3]); *(u32x4*)(merged + r * DMODEL + c) = w; } }
                } }
    }
};
struct G2Order {
    int G, c;
    __device__ bool next(int i, Unit& u) const { const int k = i / 3, n = i - 3 * k; const int pr = c + k * G; if (pr >= 256) return false; u.pm = n * 32 + (pr >> 3); u.pn = n * 8 + (pr & 7); return true; }
    __device__ __forceinline__ void a_ready(const Unit&) const {}
    __device__ __forceinline__ void done(const Unit&) const {}
};
struct EpiG3 {
    static constexpr bool PERM = true, AFTER_DRAIN = false, MID = false;
    bf16_t* out;
    __device__ __forceinline__ void operator()(const f32x4 (&acc)[2][2][4][2], const Unit& u, int wr, int wc, int fr, int fq) const {
        const int row0 = u.pm * BM + wr * 64 + fr, col0 = u.pn * BM + wc * 32 + 8 * fq;
#pragma unroll
        for (int ai = 0; ai < 2; ++ai)
#pragma unroll
            for (int m = 0; m < 4; ++m) { bf16_t* rowp = out + (size_t)(row0 + ai * HALF + m * 16) * DMODEL + col0;
#pragma unroll
                for (int bj = 0; bj < 2; ++bj) { const f32x4 v0 = acc[ai][bj][m][0], v1 = acc[ai][bj][m][1];
                    u32x4 w; w.x = cvt_pk_bf16(v0[0], v0[1]); w.y = cvt_pk_bf16(v0[2], v0[3]); w.z = cvt_pk_bf16(v1[0], v1[1]); w.w = cvt_pk_bf16(v1[2], v1[3]);
                    *(u32x4*)(rowp + bj * HALF) = w; } }
    }
};

struct EpiG2h {
    static constexpr bool PERM = true, AFTER_DRAIN = false, MID = true;
    const bf16_t* gates; bf16_t* merged;
    __device__ __forceinline__ void mid(f32x4 (&acc)[2][2][4][2], const Unit& u, int s, int wr, int wc, int fr, int fq) const {
        int row0 = u.pm * BM + wr * 64 + fr; const int col0 = u.pn * BM + wc * 32 + 8 * fq;
        asm volatile("" : "+v"(row0));
#pragma unroll
        for (int ai = 0; ai < 2; ++ai)
#pragma unroll
            for (int m = 0; m < 4; ++m) { const bf16_t* gp = gates + (size_t)(row0 + ai * HALF + m * 16) * NGATE + (s - 1) * DMODEL + col0;
#pragma unroll
                for (int bj = 0; bj < 2; ++bj) { const u32x4 a = *(const u32x4*)(gp + bj * HALF), b = *(const u32x4*)(gp + DMODEL + bj * HALF);
                    f32x4 r0, r1;
                    r0[0] = bf_lo(a.x) * __builtin_amdgcn_rcpf(bf_lo(b.x)); r0[1] = bf_hi(a.x) * __builtin_amdgcn_rcpf(bf_hi(b.x)); r0[2] = bf_lo(a.y) * __builtin_amdgcn_rcpf(bf_lo(b.y)); r0[3] = bf_hi(a.y) * __builtin_amdgcn_rcpf(bf_hi(b.y));
                    r1[0] = bf_lo(a.z) * __builtin_amdgcn_rcpf(bf_lo(b.z)); r1[1] = bf_hi(a.z) * __builtin_amdgcn_rcpf(bf_hi(b.z)); r1[2] = bf_lo(a.w) * __builtin_amdgcn_rcpf(bf_lo(b.w)); r1[3] = bf_hi(a.w) * __builtin_amdgcn_rcpf(bf_hi(b.w));
                    acc[ai][bj][m][0] *= r0; acc[ai][bj][m][1] *= r1; asm volatile("" ::: "memory"); } }
    }
    __device__ __forceinline__ void operator()(const f32x4 (&acc)[2][2][4][2], const Unit& u, int wr, int wc, int fr, int fq) const {
        const int row0 = u.pm * BM + wr * 64 + fr, col0 = u.pn * BM + wc * 32 + 8 * fq;
#pragma unroll
        for (int ai = 0; ai < 2; ++ai)
#pragma unroll
            for (int m = 0; m < 4; ++m) { const size_t r = (size_t)(row0 + ai * HALF + m * 16);
#pragma unroll
                for (int bj = 0; bj < 2; ++bj) { const int c = col0 + bj * HALF;
                    const u32x4 g = *(const u32x4*)(gates + r * NGATE + 2 * DMODEL + c);
                    const f32x4 v0 = acc[ai][bj][m][0], v1 = acc[ai][bj][m][1];
                    u32x4 w; w.x = cvt_pk_bf16(v0[0] * bf_lo(g.x), v0[1] * bf_hi(g.x)); w.y = cvt_pk_bf16(v0[2] * bf_lo(g.y), v0[3] * bf_hi(g.y));
                    w.z = cvt_pk_bf16(v1[0] * bf_lo(g.z), v1[1] * bf_hi(g.z)); w.w = cvt_pk_bf16(v1[2] * bf_lo(g.w), v1[3] * bf_hi(g.w));
                    *(u32x4*)(merged + r * DMODEL + c) = w; } }
    }
};
template <class Epi, class Sched, bool ALIGN_EPI = false, bool SP2 = false>
__device__ __forceinline__ void gemm_phase(PG8_LAS unsigned char* lds, const Gemm g, const Sched& S, const Epi& E) {
    int tid_ = threadIdx.x; asm volatile("" : "+v"(tid_));
    const int tid = tid_, wid = __builtin_amdgcn_readfirstlane(tid >> 6), lane = tid & 63, wr = wid >> 2, wc = wid & 3, fr = lane & 15, fq = lane >> 4;
    const int K = g.K, nt = K / BK;
    unsigned voffA[2], voffB[2];
#pragma unroll
    for (int i = 0; i < 2; ++i) { int R, C; stage_rc(tid * 16 + i * 8192, R, C); const int Rb = Epi::PERM ? ((R & ~31) + perm32(R & 31)) : R;
        voffA[i] = (unsigned)(R * K + C) * 2u; voffB[i] = (unsigned)(Rb * K + C) * 2u; }
    const size_t kstep = (size_t)(BK * 2);
    const size_t hstep = (size_t)HALF * K * 2;
    const size_t tstep = 2 * hstep;
    const unsigned ldsw = (unsigned)wid * 1024u;
    const int aoff = lds_byte(wr * 64 + fr, fq * 8), boff = lds_byte(wc * 32 + fr, fq * 8);
#define PG8_SA(b, h) (((b) * 2 + (h)) * HTB)
#define PG8_SB(b, h) ((4 + (b) * 2 + (h)) * HTB)
#define PG8_STAGE(bufoff, gbase, voff) do { _Pragma("unroll") for (int _i = 0; _i < 2; ++_i) \
        __builtin_amdgcn_global_load_lds((const unsigned*)((const char*)(gbase) + (voff)[_i]), (PG8_LAS unsigned*)(lds + (bufoff) + ldsw + _i * 8192), 16, 0, 0); } while (0)
#define PG8_LDA(dst, b, h) do { _Pragma("unroll") for (int m = 0; m < 4; ++m) _Pragma("unroll") for (int k = 0; k < 2; ++k) dst[m][k] = *(const PG8_LAS bf16x8*)(lds + PG8_SA(b, h) + aoff + m * 2048 + k * 1024); } while (0)
#define PG8_LDB(dst, b, h) do { _Pragma("unroll") for (int n = 0; n < 2; ++n) _Pragma("unroll") for (int k = 0; k < 2; ++k) dst[n][k] = *(const PG8_LAS bf16x8*)(lds + PG8_SB(b, h) + boff + n * 2048 + k * 1024); } while (0)
#define PG8_MMA(ai, bj, At, Bt) do { __builtin_amdgcn_s_setprio(1); _Pragma("unroll") for (int m = 0; m < 4; ++m) _Pragma("unroll") for (int n = 0; n < 2; ++n) _Pragma("unroll") for (int k = 0; k < 2; ++k) \
        acc[ai][bj][m][n] = __builtin_amdgcn_mfma_f32_16x16x32_bf16(Bt[n][k], At[m][k], acc[ai][bj][m][n], 0, 0, 0); __builtin_amdgcn_s_setprio(0); } while (0)
#define PG8_WAIT_V(n) asm volatile("s_waitcnt vmcnt(" #n ")" ::: "memory")
#define PG8_WAIT_L(n) asm volatile("s_waitcnt lgkmcnt(" #n ")" ::: "memory")
#define PG8_BAR __builtin_amdgcn_s_barrier()
#define PG8_SCHED __builtin_amdgcn_sched_barrier(0)
    Unit cur, nxt; int ui = 0;
    if (!S.next(0, cur)) return;
    f32x4 acc[2][2][4][2];
#pragma unroll
    for (int a = 0; a < 2; ++a)
#pragma unroll
        for (int b = 0; b < 2; ++b)
#pragma unroll
            for (int m = 0; m < 4; ++m)
#pragma unroll
                for (int n = 0; n < 2; ++n) acc[a][b][m][n] = (f32x4){0.f, 0.f, 0.f, 0.f};
    bf16x8 At[4][2], B0[2][2], B1[2][2];
    const char* cA = (const char*)g.A + (size_t)cur.pm * tstep; const char* cB = (const char*)g.Bt + (size_t)cur.pn * tstep;
    S.a_ready(cur);
    if constexpr (SP2) {
        PG8_STAGE(PG8_SB(0, 0), cB, voffB); PG8_STAGE(PG8_SB(0, 1), cB + hstep, voffB); PG8_STAGE(PG8_SA(0, 0), cA, voffA); PG8_STAGE(PG8_SA(0, 1), cA + hstep, voffA);
        if (wr == 1) PG8_BAR;
        PG8_WAIT_V(2); PG8_BAR;
        PG8_STAGE(PG8_SB(1, 0), cB + kstep, voffB); PG8_STAGE(PG8_SA(1, 0), cA + kstep, voffA); PG8_STAGE(PG8_SB(1, 1), cB + hstep + kstep, voffB);
        PG8_WAIT_V(6); PG8_BAR;
    } else {
        PG8_STAGE(PG8_SB(0, 0), cB, voffB); PG8_STAGE(PG8_SA(0, 0), cA, voffA); PG8_STAGE(PG8_SB(0, 1), cB + hstep, voffB); PG8_STAGE(PG8_SA(0, 1), cA + hstep, voffA);
        if (wr == 1) PG8_BAR;
        PG8_WAIT_V(4); PG8_BAR;
        PG8_STAGE(PG8_SB(1, 0), cB + kstep, voffB); PG8_STAGE(PG8_SA(1, 0), cA + kstep, voffA); PG8_STAGE(PG8_SB(1, 1), cB + hstep + kstep, voffB);
        PG8_WAIT_V(6); PG8_BAR;
    }
    for (;;) {
        const bool has_next = S.next(ui + 1, nxt);
        const char* nA = has_next ? (const char*)g.A + (size_t)nxt.pm * tstep : cA; const char* nB = has_next ? (const char*)g.Bt + (size_t)nxt.pn * tstep : cB;
        for (int t = 0; t < nt; t += 2) {
            if constexpr (Epi::MID) { if (t == 12 || t == 24) E.mid(acc, cur, t / 12, wr, wc, fr, fq); }
            const bool last = (t == nt - 2);
            const char* a1 = cA + (size_t)(t + 1) * kstep;
            const char* a2 = last ? nA : cA + (size_t)(t + 2) * kstep; const char* b2 = last ? nB : cB + (size_t)(t + 2) * kstep;
            const char* a3 = a2 + kstep; const char* b3 = b2 + kstep;
            if (last && has_next) S.a_ready(nxt);
            if constexpr (SP2) {
            PG8_LDB(B0, 0, 0); PG8_LDB(B1, 0, 1); PG8_SCHED; PG8_LDA(At, 0, 0); PG8_STAGE(PG8_SA(1, 1), a1 + hstep, voffA);
            PG8_WAIT_V(8); PG8_WAIT_L(0); PG8_BAR; PG8_MMA(0, 0, At, B0); PG8_MMA(0, 1, At, B1); PG8_BAR; PG8_SCHED;
            PG8_LDA(At, 0, 1); PG8_STAGE(PG8_SB(0, 0), b2, voffB); PG8_STAGE(PG8_SB(0, 1), b2 + hstep, voffB); PG8_STAGE(PG8_SA(0, 0), a2, voffA);
            PG8_WAIT_V(8); PG8_WAIT_L(0); PG8_BAR; PG8_MMA(1, 0, At, B0); PG8_MMA(1, 1, At, B1); PG8_BAR; PG8_SCHED;
            PG8_LDB(B0, 1, 0); PG8_LDB(B1, 1, 1); PG8_SCHED; PG8_LDA(At, 1, 0); PG8_STAGE(PG8_SA(0, 1), a2 + hstep, voffA);
            PG8_WAIT_V(8); PG8_WAIT_L(0); PG8_BAR; PG8_MMA(0, 0, At, B0); PG8_MMA(0, 1, At, B1); PG8_BAR; PG8_SCHED;
            PG8_LDA(At, 1, 1); PG8_STAGE(PG8_SB(1, 0), b3, voffB); PG8_STAGE(PG8_SB(1, 1), b3 + hstep, voffB); PG8_STAGE(PG8_SA(1, 0), a3, voffA);
            PG8_WAIT_V(8); PG8_WAIT_L(0); PG8_BAR; PG8_MMA(1, 0, At, B0); PG8_MMA(1, 1, At, B1); PG8_BAR; PG8_SCHED;
            } else {
            PG8_LDB(B0, 0, 0); PG8_SCHED; PG8_LDA(At, 0, 0); PG8_STAGE(PG8_SA(1, 1), a1 + hstep, voffA);
            PG8_WAIT_L(8); PG8_BAR; PG8_WAIT_L(0); PG8_MMA(0, 0, At, B0); PG8_BAR; PG8_SCHED;
            PG8_LDB(B1, 0, 1); PG8_STAGE(PG8_SB(0, 0), b2, voffB);
            PG8_BAR; PG8_WAIT_L(0); PG8_MMA(0, 1, At, B1); PG8_BAR;
            PG8_LDA(At, 0, 1); PG8_STAGE(PG8_SA(0, 0), a2, voffA);
            PG8_BAR; PG8_WAIT_L(0); PG8_MMA(1, 0, At, B0); PG8_BAR; PG8_SCHED;
            PG8_STAGE(PG8_SB(0, 1), b2 + hstep, voffB);
            PG8_WAIT_V(6); PG8_BAR; PG8_MMA(1, 1, At, B1); PG8_BAR;
            PG8_LDB(B0, 1, 0); PG8_SCHED; PG8_LDA(At, 1, 0); PG8_STAGE(PG8_SA(0, 1), a2 + hstep, voffA);
            PG8_WAIT_L(8); PG8_BAR; PG8_WAIT_L(0); PG8_MMA(0, 0, At, B0); PG8_BAR; PG8_SCHED;
            PG8_LDB(B1, 1, 1); PG8_STAGE(PG8_SB(1, 0), b3, voffB);
            PG8_BAR; PG8_WAIT_L(0); PG8_MMA(0, 1, At, B1); PG8_BAR;
            PG8_LDA(At, 1, 1); PG8_STAGE(PG8_SA(1, 0), a3, voffA);
            PG8_BAR; PG8_WAIT_L(0); PG8_MMA(1, 0, At, B0); PG8_BAR; PG8_SCHED;
            PG8_STAGE(PG8_SB(1, 1), b3 + hstep, voffB);
            PG8_WAIT_V(6); PG8_BAR; PG8_MMA(1, 1, At, B1); PG8_BAR;
            }
        }
        if constexpr (ALIGN_EPI) { if (wr == 0) PG8_BAR; }
        if constexpr (!Epi::AFTER_DRAIN) { E(acc, cur, wr, wc, fr, fq); S.done(cur); }
        if (!has_next) break;
#pragma unroll
        for (int a = 0; a < 2; ++a)
#pragma unroll
            for (int b = 0; b < 2; ++b)
#pragma unroll
                for (int m = 0; m < 4; ++m)
#pragma unroll
                    for (int n = 0; n < 2; ++n) acc[a][b][m][n] = (f32x4){0.f, 0.f, 0.f, 0.f};
        cur = nxt; cA = nA; cB = nB; ++ui;
        if constexpr (ALIGN_EPI) { if (wr == 1) PG8_BAR; }
    }
    PG8_WAIT_V(0);
    if constexpr (!ALIGN_EPI) { if (wr == 0) PG8_BAR; }
    PG8_BAR;
    if constexpr (Epi::AFTER_DRAIN) { E.fused(acc, cur, wr, wc, fr, fq, lds, wid, lane); S.done(cur); }
#undef PG8_SA
#undef PG8_SB
#undef PG8_STAGE
#undef PG8_LDA
#undef PG8_LDB
#undef PG8_MMA
#undef PG8_WAIT_V
#undef PG8_WAIT_L
#undef PG8_BAR
#undef PG8_SCHED
}
}

#ifndef PG8_SP2
#define PG8_SP2 true
#endif
#ifndef PG8_ALIGN
#define PG8_ALIGN true
#endif

#define LAS __attribute__((address_space(3)))
typedef unsigned short bf16_t;
typedef short bf16x8 __attribute__((ext_vector_type(8)));
typedef short s16x4 __attribute__((ext_vector_type(4)));
typedef float f32x4 __attribute__((ext_vector_type(4)));
typedef float f32x2 __attribute__((ext_vector_type(2)));
typedef unsigned u32x4 __attribute__((ext_vector_type(4)));
typedef unsigned u32x2 __attribute__((ext_vector_type(2)));
using pg8::cvt_pk_bf16; using pg8::bf_lo; using pg8::bf_hi;

constexpr int NB = 2, SEQ = 4096, DM = 2048, DEPTH = 4, M = NB * SEQ, BW = 768, DIN = 6912, NGT = 6144, N1 = DIN + NGT;
constexpr int NH = 6, YW = 3 * BW;
constexpr float EPS = 1e-6f, L2E = 1.4426950408889634f;
constexpr int NWAVES = 8, NTHR = 512;
constexpr int LDS_BYTES = 147456;

constexpr size_t SZ_W1T = (size_t)N1 * DM * 2, SZ_WBT = (size_t)3 * DM * BW * 2, SZ_WOT = (size_t)DM * DM * 2, SZ_WPT = (size_t)4 * 192 * 192 * 2;
constexpr size_t WS_W1T = 1u << 20;
constexpr size_t WS_WBT = WS_W1T + DEPTH * SZ_W1T;
constexpr size_t WS_WOT = WS_WBT + DEPTH * SZ_WBT;
constexpr size_t WS_WPT = WS_WOT + DEPTH * SZ_WOT;
constexpr size_t WS_H = (WS_WPT + DEPTH * SZ_WPT + 4095) & ~(size_t)4095;
constexpr size_t WS_PROJ = WS_H + (size_t)M * DM * 2;
constexpr size_t WS_GATES = WS_PROJ + (size_t)9 * M * BW * 2;
constexpr size_t WS_Y = WS_GATES + (size_t)M * NGT * 2;
constexpr size_t WS_MERGED = WS_Y + (size_t)3 * M * BW * 2;
constexpr size_t WS_OUT = WS_MERGED + (size_t)M * DM * 2;
constexpr size_t WS_XB = WS_OUT + (size_t)M * DM * 2;
constexpr size_t WS_END = WS_XB + (size_t)M * DM * 2;

struct Params {
    const float *x, *rel_bias, *g_pre, *w_in, *w_gate, *pool_w, *pool_scale, *lam, *subln_g, *sgu_ng, *sgu_nb, *sgu_w, *sgu_b, *w_branch, *w_out, *g_post;
    float* out; unsigned char* ws;
};

__device__ __forceinline__ float wave_sum(float v) {
#pragma unroll
    for (int o = 1; o < 64; o <<= 1) v += __shfl_xor(v, o);
    return v;
}
__device__ __forceinline__ float dot4(f32x4 a) { return (a.x * a.x + a.y * a.y) + (a.z * a.z + a.w * a.w); }

__device__ __forceinline__ void transpose_item(const float* W, int K, int N, bf16_t* WT, int row_off, LAS float* scr, int item, int lane) {
    const int nblk = N / 32, kb = item / nblk, nb = item % nblk, k0 = 64 * kb, n0 = 32 * nb;
#pragma unroll 8
    for (int i = 0; i < 32; ++i) { const int kk = 2 * i + (lane >> 5); scr[kk * 33 + (lane & 31)] = W[(size_t)(k0 + kk) * N + n0 + (lane & 31)]; }
    asm volatile("s_waitcnt lgkmcnt(0)" ::: "memory");
    const int c = lane & 7;
#pragma unroll
    for (int j = 0; j < 4; ++j) { const int n = (lane >> 3) + 8 * j; const LAS float* s = scr + (8 * c) * 33 + n;
        u32x4 o; o.x = cvt_pk_bf16(s[0 * 33], s[1 * 33]); o.y = cvt_pk_bf16(s[2 * 33], s[3 * 33]); o.z = cvt_pk_bf16(s[4 * 33], s[5 * 33]); o.w = cvt_pk_bf16(s[6 * 33], s[7 * 33]);
        *(u32x4*)(WT + (size_t)(row_off + n0 + n) * K + k0 + 8 * c) = o; }
    asm volatile("s_waitcnt lgkmcnt(0)" ::: "memory");
}

__device__ __forceinline__ void rms_row_to_bf16(const float* xrow, const float* g, bf16_t* orow, int lane) {
    const f32x4* xr = (const f32x4*)xrow + lane; const f32x4* gr = (const f32x4*)g + lane;
    f32x4 v[8]; float s = 0.f;
#pragma unroll
    for (int j = 0; j < 8; ++j) { v[j] = xr[64 * j]; s += dot4(v[j]); }
    const float rstd = 1.0f / sqrtf(wave_sum(s) * (1.f / DM) + EPS);
    u32x2* o8 = (u32x2*)orow + lane;
#pragma unroll
    for (int j = 0; j < 8; ++j) { const f32x4 gg = gr[64 * j]; u32x2 w; w.x = cvt_pk_bf16(v[j].x * rstd * gg.x, v[j].y * rstd * gg.y); w.y = cvt_pk_bf16(v[j].z * rstd * gg.z, v[j].w * rstd * gg.w); o8[64 * j] = w; }
}

constexpr int I_IN = 32 * 216, I_G = 32 * 192, I_B1 = 12 * 64, I_B = 3 * I_B1, I_O = 32 * 64, I_P1 = 18, I_P = 4 * I_P1, I_LAYER = I_IN + I_G + I_B + I_O + I_P;

__device__ __forceinline__ void convert_layer(const Params& p, int l, LAS unsigned char* lds, int gw0, int NGW) {
    int tid = threadIdx.x; asm volatile("" : "+v"(tid)); const int lane = tid & 63, wave = __builtin_amdgcn_readfirstlane(tid >> 6); const int gw = gw0 + wave;
    LAS float* scr = (LAS float*)(lds + wave * 16384);
    unsigned char* ws = p.ws;
    bf16_t* w1t = (bf16_t*)(ws + WS_W1T + l * SZ_W1T);
    for (int it = gw; it < I_LAYER; it += NGW) {
        int r = it;
        if (r < I_IN) { transpose_item(p.w_in + (size_t)l * DM * DIN, DM, DIN, w1t, 0, scr, r, lane); continue; } r -= I_IN;
        if (r < I_G) { transpose_item(p.w_gate + (size_t)l * DM * NGT, DM, NGT, w1t, DIN, scr, r, lane); continue; } r -= I_G;
        if (r < I_B) { transpose_item(p.w_branch + (size_t)l * YW * DM, YW, DM, (bf16_t*)(ws + WS_WBT + l * SZ_WBT), 0, scr, r, lane); continue; } r -= I_B;
        if (r < I_O) { transpose_item(p.w_out + (size_t)l * DM * DM, DM, DM, (bf16_t*)(ws + WS_WOT + l * SZ_WOT), 0, scr, r, lane); continue; } r -= I_O;
        { const int g = r / I_P1, rr = r - g * I_P1; transpose_item(p.pool_w + (size_t)(l * 4 + g) * 192 * 192, 192, 192, (bf16_t*)(ws + WS_WPT + l * SZ_WPT) + g * 192 * 192, 0, scr, rr, lane); }
    }
}
__device__ __forceinline__ void prologue(const Params& p, LAS unsigned char* lds, int vcu, int G, int nlayers) {
    for (int l = 0; l < nlayers; ++l) convert_layer(p, l, lds, vcu * NWAVES, G * NWAVES);
    int tid = threadIdx.x; asm volatile("" : "+v"(tid)); const int lane = tid & 63, wave = __builtin_amdgcn_readfirstlane(tid >> 6); const int gw = vcu * NWAVES + wave, NGW = G * NWAVES;
    for (int m = gw; m < M; m += NGW) rms_row_to_bf16(p.x + (size_t)m * DM, p.g_pre, (bf16_t*)(p.ws + WS_H) + (size_t)m * DM, lane);
}

__device__ __forceinline__ void rowpass(const float* xin32, bf16_t* XB, float* xout32, const bf16_t* outb, const float* gpost, const float* gnext, bf16_t* H, int vcu, int G) {
    int tid = threadIdx.x; asm volatile("" : "+v"(tid)); const int lane = tid & 63, wave = __builtin_amdgcn_readfirstlane(tid >> 6); const int gw = vcu * NWAVES + wave, NGW = G * NWAVES;
    for (int m = gw; m < M; m += NGW) {
        const u32x2* o2 = (const u32x2*)(outb + (size_t)m * DM) + lane; const f32x4* gp = (const f32x4*)gpost + lane;
        u32x2* xb2 = (u32x2*)(XB + (size_t)m * DM) + lane;
        f32x4 o[8]; float ss = 0.f;
#pragma unroll
        for (int j = 0; j < 8; ++j) { const u32x2 u = o2[64 * j]; o[j] = (f32x4){bf_lo(u.x), bf_hi(u.x), bf_lo(u.y), bf_hi(u.y)}; ss += dot4(o[j]); }
        const float rstd = 1.0f / sqrtf(wave_sum(ss) * (1.f / DM) + EPS);
        float s2 = 0.f;
        if (xin32) { const f32x4* x4 = (const f32x4*)(xin32 + (size_t)m * DM) + lane;
#pragma unroll
            for (int j = 0; j < 8; ++j) { const f32x4 g = gp[64 * j]; o[j] = x4[64 * j] + o[j] * rstd * g; s2 += dot4(o[j]); }
        } else {
#pragma unroll
            for (int j = 0; j < 8; ++j) { const f32x4 g = gp[64 * j]; const u32x2 u = xb2[64 * j]; o[j] = (f32x4){bf_lo(u.x), bf_hi(u.x), bf_lo(u.y), bf_hi(u.y)} + o[j] * rstd * g; s2 += dot4(o[j]); }
        }
        if (xout32) { f32x4* xo = (f32x4*)(xout32 + (size_t)m * DM) + lane;
#pragma unroll
            for (int j = 0; j < 8; ++j) xo[64 * j] = o[j];
        } else {
#pragma unroll
            for (int j = 0; j < 8; ++j) { u32x2 w; w.x = cvt_pk_bf16(o[j].x, o[j].y); w.y = cvt_pk_bf16(o[j].z, o[j].w); xb2[64 * j] = w; }
        }
        if (gnext) {
            const float r2 = 1.0f / sqrtf(wave_sum(s2) * (1.f / DM) + EPS);
            const f32x4* gn = (const f32x4*)gnext + lane; u32x2* h8 = (u32x2*)(H + (size_t)m * DM) + lane;
#pragma unroll
            for (int j = 0; j < 8; ++j) { const f32x4 g = gn[64 * j]; u32x2 w; w.x = cvt_pk_bf16(o[j].x * r2 * g.x, o[j].y * r2 * g.y); w.y = cvt_pk_bf16(o[j].z * r2 * g.z, o[j].w * r2 * g.w); h8[64 * j] = w; }
        }
    }
}

__device__ __forceinline__ bf16x8 mk8(u32x4 v) { return __builtin_bit_cast(bf16x8, v); }
#define MFMA16(a, b, c) __builtin_amdgcn_mfma_f32_16x16x32_bf16((a), (b), (c), 0, 0, 0)

__device__ __forceinline__ void pool_unit(LAS unsigned char* lds, int u, const bf16_t* ax, const bf16_t* ag, const bf16_t* wpt, const float* pscale, bf16_t* y0) {
    int tid = threadIdx.x; asm volatile("" : "+v"(tid)); const int lane = tid & 63, wave = __builtin_amdgcn_readfirstlane(tid >> 6);
    const int tt = u >> 2, g = u & 3, wl = 2 << g, t0 = tt * 128;
    constexpr int POOL_RAW = 51200;
    { const bool head = ((t0 & (SEQ - 1)) == 0);
      u32x4 v[7];
#pragma unroll
      for (int i = 0; i < 7; ++i) { const int it = tid + i * NTHR, rr = it / 24, ch = it - rr * 24;
          v[i] = (u32x4){0u, 0u, 0u, 0u};
          if (it < 143 * 24 && !(head && rr < 15)) v[i] = *(const u32x4*)(ax + (size_t)(t0 - 15 + rr) * BW + g * 192 + ch * 8); }
#pragma unroll
      for (int i = 0; i < 7; ++i) { const int it = tid + i * NTHR, rr = it / 24, ch = it - rr * 24;
          if (it < 143 * 24) *(LAS u32x4*)(lds + POOL_RAW + rr * 400 + ch * 16) = v[i]; }
    }
    __syncthreads();
#pragma unroll 2
    for (int i6 = 0; i6 < 6; ++i6) { const int it = tid + i6 * NTHR;
        const int r = it / 24, ch = it - r * 24; const int ts = (t0 + r) & (SEQ - 1);
        const int cnt = (ts + 1 < wl) ? ts + 1 : wl;
        const LAS unsigned char* src = lds + POOL_RAW + (r + 15) * 400 + ch * 16;
        const u32x4 cur = *(const LAS u32x4*)src;
        const f32x4 xa = {bf_lo(cur.x), bf_hi(cur.x), bf_lo(cur.y), bf_hi(cur.y)}, xb = {bf_lo(cur.z), bf_hi(cur.z), bf_lo(cur.w), bf_hi(cur.w)};
        f32x4 sa = xa, sb = xb;
        for (int k = 1; k < cnt; ++k) { const u32x4 v = *(const LAS u32x4*)(src - k * 400);
            sa += (f32x4){bf_lo(v.x), bf_hi(v.x), bf_lo(v.y), bf_hi(v.y)}; sb += (f32x4){bf_lo(v.z), bf_hi(v.z), bf_lo(v.w), bf_hi(v.w)}; }
        const float ic = 1.0f / (float)cnt;
        sa = sa * ic - xa; sb = sb * ic - xb;
        u32x4 w; w.x = cvt_pk_bf16(sa.x, sa.y); w.y = cvt_pk_bf16(sa.z, sa.w); w.z = cvt_pk_bf16(sb.x, sb.y); w.w = cvt_pk_bf16(sb.z, sb.w);
        *(LAS u32x4*)(lds + r * 400 + ch * 16) = w;
    }
    __syncthreads();
    const int fr = lane & 15, fq = lane >> 4;
    for (int dt = wave; dt < 12; dt += 8) {
        const bf16_t* wbase = wpt + g * 192 * 192 + (16 * dt + fr) * 192 + fq * 8;
        bf16x8 wf[6];
#pragma unroll
        for (int ks = 0; ks < 6; ++ks) wf[ks] = *(const bf16x8*)(wbase + ks * 32);
        const int col = g * 192 + 16 * dt + 4 * fq;
        const f32x4 sc = *(const f32x4*)(pscale + col);
        u32x2 gg8[8];
#pragma unroll
        for (int tt = 0; tt < 8; ++tt) gg8[tt] = *(const u32x2*)(ag + (size_t)(t0 + 16 * tt + fr) * BW + col);
#pragma unroll
        for (int tt = 0; tt < 8; ++tt) {
            const int t = t0 + 16 * tt + fr;
            const u32x2 gg = gg8[tt];
            const LAS unsigned char* prow = lds + (16 * tt + fr) * 400 + fq * 16;
            f32x4 acc = {0.f, 0.f, 0.f, 0.f};
#pragma unroll
            for (int ks = 0; ks < 6; ++ks) { const bf16x8 pf = *(const LAS bf16x8*)(prow + ks * 64); acc = MFMA16(wf[ks], pf, acc); }
            const f32x4 v = acc * sc * (f32x4){bf_lo(gg.x), bf_hi(gg.x), bf_lo(gg.y), bf_hi(gg.y)};
            u32x2 w; w.x = cvt_pk_bf16(v.x, v.y); w.y = cvt_pk_bf16(v.z, v.w); *(u32x2*)(y0 + (size_t)t * YW + col) = w;
        }
    }
    __syncthreads();
}

typedef short v4i16s_t __attribute__((ext_vector_type(4)));
__device__ __forceinline__ s16x4 vtr_s(const LAS unsigned char* p) { return __builtin_bit_cast(s16x4, __builtin_amdgcn_ds_read_tr16_b64_v4i16((LAS v4i16s_t*)p)); }
__device__ __forceinline__ void sgu_unit(LAS unsigned char* lds, int u, const bf16_t* cu, const bf16_t* cv, const bf16_t* cgt, const float* ng, const float* nb, const float* wsf, const float* bs, bf16_t* y2) {
    int tid = threadIdx.x; asm volatile("" : "+v"(tid)); const int lane = tid & 63, wave = __builtin_amdgcn_readfirstlane(tid >> 6);
    const int ci = u / 6, g = u - 6 * ci, t0 = ci * 128;
    const int fr = lane & 15, fq = lane >> 4;
    LAS f32x2* stats = (LAS f32x2*)(lds + 36864);
#pragma unroll
    for (int i = 0; i < 4; ++i) { const int row = 16 * wave + 4 * i + fq; const u32x4* src = (const u32x4*)(cv + (size_t)(t0 + row) * BW) + fr;
        u32x4 v[6];
#pragma unroll
        for (int c = 0; c < 6; ++c) v[c] = src[16 * c];
        float s = 0.f, s2 = 0.f;
#pragma unroll
        for (int c = 0; c < 6; ++c) { const float a0 = bf_lo(v[c].x), a1 = bf_hi(v[c].x), a2 = bf_lo(v[c].y), a3 = bf_hi(v[c].y), a4 = bf_lo(v[c].z), a5 = bf_hi(v[c].z), a6 = bf_lo(v[c].w), a7 = bf_hi(v[c].w);
            s += ((a0 + a1) + (a2 + a3)) + ((a4 + a5) + (a6 + a7)); s2 += ((a0 * a0 + a1 * a1) + (a2 * a2 + a3 * a3)) + ((a4 * a4 + a5 * a5) + (a6 * a6 + a7 * a7)); }
#pragma unroll
        for (int o = 1; o < 16; o <<= 1) { s += __shfl_xor(s, o); s2 += __shfl_xor(s2, o); }
        const float mean = s * (1.f / BW); float var = s2 * (1.f / BW) - mean * mean; var = var > 0.f ? var : 0.f;
        if (fr == 0) stats[row] = (f32x2){mean, 1.0f / sqrtf(var + EPS)};
    }
    __syncthreads();
#pragma unroll
    for (int it = 0; it < 4; ++it) { const int item = tid + NTHR * it, chn = item & 15, q = item >> 4;
        const f32x2 st = stats[q]; const u32x4 v = *(const u32x4*)(cv + (size_t)(t0 + q) * BW + g * 128 + chn * 8);
        const f32x4 ga = *(const f32x4*)(ng + g * 128 + chn * 8), gb = *(const f32x4*)(ng + g * 128 + chn * 8 + 4), ba = *(const f32x4*)(nb + g * 128 + chn * 8), bb = *(const f32x4*)(nb + g * 128 + chn * 8 + 4);
        f32x4 xa = {bf_lo(v.x), bf_hi(v.x), bf_lo(v.y), bf_hi(v.y)}, xb = {bf_lo(v.z), bf_hi(v.z), bf_lo(v.w), bf_hi(v.w)};
        xa = (xa - st.x) * st.y * ga + ba; xb = (xb - st.x) * st.y * gb + bb;
        u32x4 w; w.x = cvt_pk_bf16(xa.x, xa.y); w.y = cvt_pk_bf16(xa.z, xa.w); w.z = cvt_pk_bf16(xb.x, xb.y); w.w = cvt_pk_bf16(xb.z, xb.w);
        *(LAS u32x4*)(lds + q * 288 + chn * 16) = w;
    }
    __syncthreads();
    const int pp = 16 * wave + fr;
    f32x4 acc[8];
#pragma unroll
    for (int c = 0; c < 8; ++c) acc[c] = (f32x4){0.f, 0.f, 0.f, 0.f};
    f32x4 wa[4], wb[4];
#pragma unroll
    for (int ks = 0; ks < 4; ++ks) { const float* wp = wsf + (size_t)(g * 128 + pp) * 128 + 32 * ks + 4 * fq; wa[ks] = *(const f32x4*)wp; wb[ks] = *(const f32x4*)(wp + 16); }
    u32x2 uu[8], gg8[8];
#pragma unroll
    for (int c = 0; c < 8; ++c) { const int col = g * 128 + 16 * c + 4 * fq; uu[c] = *(const u32x2*)(cu + (size_t)(t0 + pp) * BW + col); gg8[c] = *(const u32x2*)(cgt + (size_t)(t0 + pp) * BW + col); }
    const LAS unsigned char* Vb = lds + (4 * fq + ((lane & 15) >> 2)) * 288 + (lane & 3) * 8;
#pragma unroll
    for (int ks = 0; ks < 4; ++ks) {
        if (32 * ks <= 16 * wave + 15) {
            const int q0 = 32 * ks + 4 * fq;
            f32x4 a = wa[ks], b = wb[ks];
            a.x = (q0 + 0 <= pp) ? a.x : 0.f; a.y = (q0 + 1 <= pp) ? a.y : 0.f; a.z = (q0 + 2 <= pp) ? a.z : 0.f; a.w = (q0 + 3 <= pp) ? a.w : 0.f;
            b.x = (q0 + 16 <= pp) ? b.x : 0.f; b.y = (q0 + 17 <= pp) ? b.y : 0.f; b.z = (q0 + 18 <= pp) ? b.z : 0.f; b.w = (q0 + 19 <= pp) ? b.w : 0.f;
            u32x4 wv; wv.x = cvt_pk_bf16(a.x, a.y); wv.y = cvt_pk_bf16(a.z, a.w); wv.z = cvt_pk_bf16(b.x, b.y); wv.w = cvt_pk_bf16(b.z, b.w);
            const bf16x8 wf = mk8(wv);
#pragma unroll
            for (int c = 0; c < 8; ++c) { const s16x4 lo = vtr_s(Vb + (32 * ks) * 288 + c * 32), hi = vtr_s(Vb + (32 * ks + 16) * 288 + c * 32);
                const bf16x8 vf = (bf16x8){lo[0], lo[1], lo[2], lo[3], hi[0], hi[1], hi[2], hi[3]};
                acc[c] = MFMA16(vf, wf, acc[c]); }
        }
    }
    const int t = t0 + pp; const float bias = bs[g * 128 + pp];
#pragma unroll
    for (int c = 0; c < 8; ++c) { const int col = g * 128 + 16 * c + 4 * fq;
        const f32x4 v = (acc[c] + bias) * (f32x4){bf_lo(uu[c].x), bf_hi(uu[c].x), bf_lo(uu[c].y), bf_hi(uu[c].y)} * (f32x4){bf_lo(gg8[c].x), bf_hi(gg8[c].x), bf_lo(gg8[c].y), bf_hi(gg8[c].y)};
        u32x2 w; w.x = cvt_pk_bf16(v.x, v.y); w.y = cvt_pk_bf16(v.z, v.w); *(u32x2*)(y2 + (size_t)t * YW + col) = w; }
    __syncthreads();
}

constexpr int AK_STRIDE = 272, AV_STRIDE = 288, AK_BYTES = 64 * AK_STRIDE, AV_BYTES = 64 * AV_STRIDE, AV_OFF = 2 * AK_BYTES, ATBL_OFF = AV_OFF + 2 * AV_BYTES;
typedef short v4i16_t __attribute__((ext_vector_type(4)));
__device__ __forceinline__ s16x4 vtr(const LAS unsigned char* p) { return __builtin_bit_cast(s16x4, __builtin_amdgcn_ds_read_tr16_b64_v4i16((LAS v4i16_t*)p)); }

__device__ __forceinline__ float xmax16(float v) { auto r = __builtin_amdgcn_permlane16_swap(__float_as_uint(v), __float_as_uint(v), false, false); return fmaxf(__uint_as_float(r[0]), __uint_as_float(r[1])); }
__device__ __forceinline__ float xmax32(float v) { auto r = __builtin_amdgcn_permlane32_swap(__float_as_uint(v), __float_as_uint(v), false, false); return fmaxf(__uint_as_float(r[0]), __uint_as_float(r[1])); }
__device__ __forceinline__ void attn_unit(LAS unsigned char* lds, int bh, int qb, const bf16_t* Qs, const bf16_t* Ks, const bf16_t* Vs, const bf16_t* bg, const float* rel_bias, const float* lam, const float* subg, float lambda_init, bf16_t* y1) {
    int tid = threadIdx.x; asm volatile("" : "+v"(tid)); const int lane = tid & 63, wave = __builtin_amdgcn_readfirstlane(tid >> 6);
    const int b = bh / NH, h = bh - NH * b;
    const int fr = lane & 15, fq = lane >> 4;
    const int nt = 2 * qb + 2, jmax = 2 * qb + (wave >> 2), jnear = 2 * qb - 2;
    LAS float* tbl = (LAS float*)(lds + ATBL_OFF);
    { const int rel = tid - 256, n = rel < 0 ? -rel : rel;
      const int large = 8 + (n >= 12) + (n >= 16) + (n >= 23) + (n >= 32) + (n >= 46) + (n >= 64) + (n >= 91);
      const int bucket = (rel > 0 ? 16 : 0) + (n < 8 ? n : large);
      tbl[tid] = rel_bias[bucket * NH + h] * L2E; }
    const float c15 = rel_bias[15 * NH + h] * L2E;
    float lam_full;
    { const float a = lam[lane] * lam[64 + lane], c = lam[128 + lane] * lam[192 + lane]; lam_full = __expf(wave_sum(a)) - __expf(wave_sum(c)) + lambda_init; }
    const size_t rowbase = (size_t)b * SEQ;
    const int qpos = 128 * qb + 16 * wave + fr;
    bf16x8 qf[2][2];
    { const bf16_t* qp = Qs + (rowbase + qpos) * BW + h * 128 + fq * 8;
#pragma unroll
      for (int br = 0; br < 2; ++br)
#pragma unroll
          for (int ks = 0; ks < 2; ++ks) qf[br][ks] = *(const bf16x8*)(qp + br * 64 + ks * 32); }
    const int srow = tid >> 4, sch = tid & 15;
    const bf16_t* kg = Ks + (rowbase + srow) * BW + h * 128 + sch * 8;
    const bf16_t* vg = Vs + (rowbase + srow) * BW + h * 128 + sch * 8;
    u32x4 sk0, sk1, sv0, sv1;
    sk0 = *(const u32x4*)kg; sk1 = *(const u32x4*)(kg + 32 * BW); sv0 = *(const u32x4*)vg; sv1 = *(const u32x4*)(vg + 32 * BW);
    *(LAS u32x4*)(lds + srow * AK_STRIDE + sch * 16) = sk0; *(LAS u32x4*)(lds + (srow + 32) * AK_STRIDE + sch * 16) = sk1;
    *(LAS u32x4*)(lds + AV_OFF + srow * AV_STRIDE + sch * 16) = sv0; *(LAS u32x4*)(lds + AV_OFF + (srow + 32) * AV_STRIDE + sch * 16) = sv1;
    { const size_t adv = (size_t)64 * BW;
      sk0 = *(const u32x4*)(kg + adv); sk1 = *(const u32x4*)(kg + adv + 32 * BW); sv0 = *(const u32x4*)(vg + adv); sv1 = *(const u32x4*)(vg + adv + 32 * BW); }
#define A_BAR() do { asm volatile("s_waitcnt lgkmcnt(0)" ::: "memory"); __builtin_amdgcn_s_barrier(); asm volatile("" ::: "memory"); } while (0)
#define A_STAGE(jj) do { if ((jj) + 1 < nt) { const int bo = (((jj) + 1) & 1); \
        *(LAS u32x4*)(lds + bo * AK_BYTES + srow * AK_STRIDE + sch * 16) = sk0; *(LAS u32x4*)(lds + bo * AK_BYTES + (srow + 32) * AK_STRIDE + sch * 16) = sk1; \
        *(LAS u32x4*)(lds + AV_OFF + bo * AV_BYTES + srow * AV_STRIDE + sch * 16) = sv0; *(LAS u32x4*)(lds + AV_OFF + bo * AV_BYTES + (srow + 32) * AV_STRIDE + sch * 16) = sv1; \
        if ((jj) + 2 < nt) { const size_t adv = (size_t)((jj) + 2) * 64 * BW; \
            sk0 = *(const u32x4*)(kg + adv); sk1 = *(const u32x4*)(kg + adv + 32 * BW); sv0 = *(const u32x4*)(vg + adv); sv1 = *(const u32x4*)(vg + adv + 32 * BW); } } } while (0)
    A_BAR();
    f32x4 o1[8], o2[8];
#pragma unroll
    for (int d = 0; d < 8; ++d) { o1[d] = (f32x4){0.f, 0.f, 0.f, 0.f}; o2[d] = (f32x4){0.f, 0.f, 0.f, 0.f}; }
    float m1 = -1e30f, m2 = -1e30f, l1 = 0.f, l2 = 0.f;
    const float CS = 0.125f * L2E;
    const int kvoff = fr * AK_STRIDE + fq * 16;
    const int vvoff = (4 * fq + ((lane & 15) >> 2)) * AV_STRIDE + (lane & 3) * 8;
    const int half = wave >> 2;
    if (half) A_BAR();
    for (int j = 0; j < nt; ++j) {
        bf16x8 p1[2], p2[2];
        if (j <= jmax) {
            const LAS unsigned char* Kb = lds + (j & 1) * AK_BYTES + kvoff;
            f32x4 s1[4], s2[4];
#pragma unroll
            for (int kt = 0; kt < 4; ++kt) {
                const bf16x8 k00 = *(const LAS bf16x8*)(Kb + kt * 16 * AK_STRIDE), k01 = *(const LAS bf16x8*)(Kb + kt * 16 * AK_STRIDE + 64);
                const bf16x8 k10 = *(const LAS bf16x8*)(Kb + kt * 16 * AK_STRIDE + 128), k11 = *(const LAS bf16x8*)(Kb + kt * 16 * AK_STRIDE + 192);
                f32x4 z = {0.f, 0.f, 0.f, 0.f};
                s1[kt] = MFMA16(k00, qf[0][0], z); s1[kt] = MFMA16(k01, qf[0][1], s1[kt]);
                s2[kt] = MFMA16(k10, qf[1][0], z); s2[kt] = MFMA16(k11, qf[1][1], s2[kt]);
            }
            const bool near = (j >= jnear);
            if (near) {
                const int ib = 64 * j + 4 * fq - qpos + 256;
#pragma unroll
                for (int kt = 0; kt < 4; ++kt) {
                    const float b0 = tbl[ib + 16 * kt], b1 = tbl[ib + 16 * kt + 1], b2 = tbl[ib + 16 * kt + 2], b3 = tbl[ib + 16 * kt + 3];
                    s1[kt].x = s1[kt].x * CS + b0; s1[kt].y = s1[kt].y * CS + b1; s1[kt].z = s1[kt].z * CS + b2; s1[kt].w = s1[kt].w * CS + b3;
                    s2[kt].x = s2[kt].x * CS + b0; s2[kt].y = s2[kt].y * CS + b1; s2[kt].z = s2[kt].z * CS + b2; s2[kt].w = s2[kt].w * CS + b3;
                }
            }
            float x1 = fmaxf(fmaxf(fmaxf(s1[0].x, s1[0].y), fmaxf(s1[0].z, s1[0].w)), fmaxf(fmaxf(s1[1].x, s1[1].y), fmaxf(s1[1].z, s1[1].w)));
            x1 = fmaxf(x1, fmaxf(fmaxf(fmaxf(s1[2].x, s1[2].y), fmaxf(s1[2].z, s1[2].w)), fmaxf(fmaxf(s1[3].x, s1[3].y), fmaxf(s1[3].z, s1[3].w))));
            float x2 = fmaxf(fmaxf(fmaxf(s2[0].x, s2[0].y), fmaxf(s2[0].z, s2[0].w)), fmaxf(fmaxf(s2[1].x, s2[1].y), fmaxf(s2[1].z, s2[1].w)));
            x2 = fmaxf(x2, fmaxf(fmaxf(fmaxf(s2[2].x, s2[2].y), fmaxf(s2[2].z, s2[2].w)), fmaxf(fmaxf(s2[3].x, s2[3].y), fmaxf(s2[3].z, s2[3].w))));
            x1 = xmax16(x1); x1 = xmax32(x1); x2 = xmax16(x2); x2 = xmax32(x2);
            const float sc = near ? 1.0f : CS, cb = near ? 0.0f : c15;
            const float cand1 = x1 * sc + cb, cand2 = x2 * sc + cb;
            if (__builtin_amdgcn_ballot_w64(cand1 > m1 + 8.0f) != 0ull) { const float mn = fmaxf(m1, cand1), al = __builtin_amdgcn_exp2f(m1 - mn); m1 = mn; l1 *= al;
#pragma unroll
                for (int d = 0; d < 8; ++d) o1[d] = o1[d] * al; }
            if (__builtin_amdgcn_ballot_w64(cand2 > m2 + 8.0f) != 0ull) { const float mn = fmaxf(m2, cand2), al = __builtin_amdgcn_exp2f(m2 - mn); m2 = mn; l2 *= al;
#pragma unroll
                for (int d = 0; d < 8; ++d) o2[d] = o2[d] * al; }
            const float of1 = cb - m1, of2 = cb - m2;
            float r1 = 0.f, r2 = 0.f;
#pragma unroll
            for (int kt = 0; kt < 4; ++kt) {
                s1[kt].x = __builtin_amdgcn_exp2f(s1[kt].x * sc + of1); s1[kt].y = __builtin_amdgcn_exp2f(s1[kt].y * sc + of1); s1[kt].z = __builtin_amdgcn_exp2f(s1[kt].z * sc + of1); s1[kt].w = __builtin_amdgcn_exp2f(s1[kt].w * sc + of1);
                s2[kt].x = __builtin_amdgcn_exp2f(s2[kt].x * sc + of2); s2[kt].y = __builtin_amdgcn_exp2f(s2[kt].y * sc + of2); s2[kt].z = __builtin_amdgcn_exp2f(s2[kt].z * sc + of2); s2[kt].w = __builtin_amdgcn_exp2f(s2[kt].w * sc + of2);
                r1 += (s1[kt].x + s1[kt].y) + (s1[kt].z + s1[kt].w); r2 += (s2[kt].x + s2[kt].y) + (s2[kt].z + s2[kt].w);
            }
            l1 += r1; l2 += r2;
#pragma unroll
            for (int st = 0; st < 2; ++st) {
                u32x4 a; a.x = cvt_pk_bf16(s1[2 * st].x, s1[2 * st].y); a.y = cvt_pk_bf16(s1[2 * st].z, s1[2 * st].w); a.z = cvt_pk_bf16(s1[2 * st + 1].x, s1[2 * st + 1].y); a.w = cvt_pk_bf16(s1[2 * st + 1].z, s1[2 * st + 1].w);
                u32x4 c; c.x = cvt_pk_bf16(s2[2 * st].x, s2[2 * st].y); c.y = cvt_pk_bf16(s2[2 * st].z, s2[2 * st].w); c.z = cvt_pk_bf16(s2[2 * st + 1].x, s2[2 * st + 1].y); c.w = cvt_pk_bf16(s2[2 * st + 1].z, s2[2 * st + 1].w);
                p1[st] = mk8(a); p2[st] = mk8(c);
            }
        }
        if (half) A_STAGE(j);
        A_BAR();
        if (j <= jmax) {
            const LAS unsigned char* Vb = lds + AV_OFF + (j & 1) * AV_BYTES + vvoff;
            __builtin_amdgcn_s_setprio(1);
#pragma unroll
            for (int d = 0; d < 8; ++d)
#pragma unroll
                for (int st = 0; st < 2; ++st) {
                    const s16x4 lo = vtr(Vb + (32 * st) * AV_STRIDE + d * 32), hi = vtr(Vb + (32 * st + 16) * AV_STRIDE + d * 32);
                    const bf16x8 vf = (bf16x8){lo[0], lo[1], lo[2], lo[3], hi[0], hi[1], hi[2], hi[3]};
                    o1[d] = MFMA16(vf, p1[st], o1[d]); o2[d] = MFMA16(vf, p2[st], o2[d]);
                }
            __builtin_amdgcn_s_setprio(0);
        }
        if (!half) A_STAGE(j);
        A_BAR();
    }
    if (!half) A_BAR();
#undef A_BAR
#undef A_STAGE
    l1 += __shfl_xor(l1, 16); l1 += __shfl_xor(l1, 32); l2 += __shfl_xor(l2, 16); l2 += __shfl_xor(l2, 32);
    const float i1 = 1.0f / l1, i2 = lam_full / l2;
    float ss = 0.f;
#pragma unroll
    for (int d = 0; d < 8; ++d) { o1[d] = o1[d] * i1 - o2[d] * i2; ss += dot4(o1[d]); }
    ss += __shfl_xor(ss, 16); ss += __shfl_xor(ss, 32);
    const float rs = (1.0f / sqrtf(ss * (1.f / 128.f) + EPS)) * (1.0f - lambda_init);
    const size_t t = rowbase + qpos;
#pragma unroll
    for (int d = 0; d < 8; ++d) { const int dv = 16 * d + 4 * fq; const int col = h * 128 + dv;
        const f32x4 sg = *(const f32x4*)(subg + dv); const u32x2 gg = *(const u32x2*)(bg + t * BW + col);
        const f32x4 v = o1[d] * rs * sg * (f32x4){bf_lo(gg.x), bf_hi(gg.x), bf_lo(gg.y), bf_hi(gg.y)};
        u32x2 w; w.x = cvt_pk_bf16(v.x, v.y); w.y = cvt_pk_bf16(v.z, v.w); *(u32x2*)(y1 + t * YW + col) = w; }
}

#define XB_TMO      128
#define XB_XCNT(j)  (256  + 64 * (j))
#define XB_XSUB(j)  (1280 + 64 * (j))
#define XB_XGEN(j)  (2304 + 64 * (j))
#define XB_TOP      3328
#define XB_TOPGEN   3392
#define XCD_BAR_WORDS 3456
#define XB_SPIN_CAP (1u << 18)

__device__ __forceinline__ unsigned xb_ld(unsigned* p)              { return __hip_atomic_load(p, __ATOMIC_RELAXED, __HIP_MEMORY_SCOPE_AGENT); }
__device__ __forceinline__ unsigned xb_add(unsigned* p, unsigned v) { return __hip_atomic_fetch_add(p, v, __ATOMIC_RELAXED, __HIP_MEMORY_SCOPE_AGENT); }
__device__ __forceinline__ unsigned xb_xcc_id() { return (unsigned)__builtin_amdgcn_s_getreg((3 << 11) | 20) & 0xFu; }
#define XB_SPIN(cond, bar) do { unsigned _sp = 0; while (cond) { __builtin_amdgcn_s_sleep(1); \
    if ((++_sp & 255u) == 0u) { if (xb_ld(&(bar)[XB_TMO])) break; if (_sp > XB_SPIN_CAP) { atomicAdd(&(bar)[XB_TMO], 1u); break; } } } } while (0)

struct XcdBarrier {
    unsigned* bar; unsigned x;
    volatile LAS unsigned* st;
};

__device__ __forceinline__ XcdBarrier xcd_barrier_post(unsigned* bar, volatile LAS unsigned* st) {
    XcdBarrier b; b.bar = bar; b.x = xb_xcc_id(); b.st = st;
    if (threadIdx.x == 0) (void)xb_add(&bar[XB_XCNT(b.x)], 1u);
    return b;
}
__device__ __forceinline__ void xcd_barrier_complete(unsigned* bar, unsigned x, unsigned& nloc, unsigned& nx) {
    const unsigned G = gridDim.x * gridDim.y * gridDim.z;
    unsigned sum, cnt, mine, sp = 0u;
    for (;;) {
        sum = 0u; cnt = 0u; mine = 0u;
#pragma unroll
        for (unsigned j = 0; j < 16; ++j) { const unsigned c = xb_ld(&bar[XB_XCNT(j)]); sum += c; cnt += (c > 0u) ? 1u : 0u; mine = (j == x) ? c : mine; }
        if (sum == G) break;
        __builtin_amdgcn_s_sleep(1);
        if ((++sp & 255u) == 0u) { if (xb_ld(&bar[XB_TMO])) break; if (sp > XB_SPIN_CAP) { atomicAdd(&bar[XB_TMO], 1u); break; } }
    }
    nloc = mine > 0u ? mine : 1u; nx = cnt > 0u ? cnt : 1u;
}

__device__ __forceinline__ void xcd_barrier(const XcdBarrier& b) {
    asm volatile("s_waitcnt vmcnt(0)" ::: "memory");
    __syncthreads();
    if (threadIdx.x == 0) {
        unsigned* bar = b.bar;
        __builtin_amdgcn_s_waitcnt(0);
        unsigned nloc = b.st[0], nx = b.st[1];
        if (nloc == 0u) { xcd_barrier_complete(bar, b.x, nloc, nx); b.st[0] = nloc; b.st[1] = nx; }
        const unsigned old = xb_add(&bar[XB_XSUB(b.x)], 1u);
        const unsigned gen = old / nloc;
        if (old + 1u == (gen + 1u) * nloc) {
            __builtin_amdgcn_fence(__ATOMIC_RELEASE, "agent");
            asm volatile("s_waitcnt vmcnt(0)" ::: "memory");
            const unsigned og = xb_add(&bar[XB_TOP], 1u);
            const unsigned tg = og / nx;
            if (og + 1u == (tg + 1u) * nx) xb_add(&bar[XB_TOPGEN], 1u);
            else XB_SPIN(xb_ld(&bar[XB_TOPGEN]) == tg, bar);
            __builtin_amdgcn_fence(__ATOMIC_ACQUIRE, "agent");
            xb_add(&bar[XB_XGEN(b.x)], 1u);
            asm volatile("s_waitcnt vmcnt(0)" ::: "memory");
        } else {
            XB_SPIN(xb_ld(&bar[XB_XGEN(b.x)]) == gen, bar);
            __builtin_amdgcn_fence(__ATOMIC_ACQUIRE, "agent");
            asm volatile("s_waitcnt vmcnt(0)" ::: "memory");
        }
    }
    __syncthreads();
}

#define GSYNC() do { xcd_barrier(xb); if (REP_MASK & 16) xcd_barrier(xb); } while (0)
constexpr int MISC_OFF = 131072 + 256;
constexpr int QCTR_WORD = 4096;
#ifndef DEFER_REDUNDANT
#define DEFER_REDUNDANT 1
#endif
#ifndef DEFER_FIRST
#define DEFER_FIRST 0
#endif
#ifndef DEFER_COLS
#define DEFER_COLS 0
#endif
struct DeferOrder { int idx; __device__ bool next(int i, pg8::Unit& u) const { if (i > 0 || idx < 0 || idx >= 96) return false; u.pm = idx & 31; u.pn = 48 + (idx >> 5); return true; }
    __device__ __forceinline__ void a_ready(const pg8::Unit&) const {} __device__ __forceinline__ void done(const pg8::Unit&) const {} };

__global__ void __launch_bounds__(NTHR) mega_fwd(Params p) {
    extern __shared__ __attribute__((aligned(16))) unsigned char lds_raw[];
    cg::grid_group grid = cg::this_grid();
    LAS unsigned char* lds = (LAS unsigned char*)lds_raw;
    const int G = gridDim.x, bx = blockIdx.x;
    const int vcu = (G % 8 == 0) ? (bx % 8) * (G / 8) + bx / 8 : bx;
    unsigned char* ws = p.ws;
    bf16_t* H = (bf16_t*)(ws + WS_H); bf16_t* PROJ = (bf16_t*)(ws + WS_PROJ); bf16_t* GATES = (bf16_t*)(ws + WS_GATES); bf16_t* Y = (bf16_t*)(ws + WS_Y);
    bf16_t* MERGED = (bf16_t*)(ws + WS_MERGED); bf16_t* OUTB = (bf16_t*)(ws + WS_OUT); bf16_t* XB = (bf16_t*)(ws + WS_XB);
    const size_t SEC = (size_t)M * BW;

    unsigned* barw = (unsigned*)ws;
    { int t0 = threadIdx.x; if (bx == 0) { for (int i = t0; i < XCD_BAR_WORDS; i += NTHR) barw[i] = 0u; if (t0 < DEPTH) barw[QCTR_WORD + 64 * t0] = (unsigned)G; }
      if (t0 < 4) ((volatile LAS unsigned*)(lds + MISC_OFF))[t0] = 0u; }
    __syncthreads();
    const bool shadow = false;
    prologue(p, lds, vcu, G, shadow ? 1 : DEPTH);
    grid.sync();
    XcdBarrier xb = xcd_barrier_post(barw, (volatile LAS unsigned*)(lds + MISC_OFF));

    for (int l = 0; l < DEPTH; ++l) {
        const float lambda_init = 0.8f - 0.6f * __expf(-0.3f * (float)l);
#ifndef NO_G1
        for (int rep = 0; rep < ((REP_MASK & 4) ? 2 : 1); ++rep)
        { pg8::Gemm g{H, (const bf16_t*)(ws + WS_W1T + l * SZ_W1T), M, N1, DM}; pg8::StaticOrder S; S.init(M, N1 - (DEFER_REDUNDANT ? 0 : DEFER_COLS), G, bx);
          pg8::EpiG1 E{PROJ, GATES};
          pg8::gemm_phase<pg8::EpiG1, pg8::StaticOrder, true, true>(lds, g, S, E); }
        if (shadow && l + 1 < DEPTH && bx >= 96) convert_layer(p, l + 1, lds, (bx - 96) * NWAVES, 160 * NWAVES);
#endif
        GSYNC();
        {
#define ATTN_U(bh_, qb_) attn_unit(lds, (bh_), (qb_), PROJ + 2 * SEC, PROJ + 3 * SEC, PROJ + 4 * SEC, PROJ + 5 * SEC, p.rel_bias, p.lam + l * 256, p.subln_g + l * 128, lambda_init, Y + BW)
#define MIX_U(j_) do { const int jj_ = (j_); if (jj_ < 384) sgu_unit(lds, jj_, PROJ + 6 * SEC, PROJ + 7 * SEC, PROJ + 8 * SEC, p.sgu_ng + l * BW, p.sgu_nb + l * BW, p.sgu_w + (size_t)l * 6 * 128 * 128, p.sgu_b + l * 6 * 128, Y + 2 * BW); \
                         else pool_unit(lds, jj_ - 384, PROJ, PROJ + SEC, (const bf16_t*)(ws + WS_WPT + l * SZ_WPT), p.pool_scale + l * BW, Y); } while (0)
          if (G == 256) {
              const int x = vcu >> 5, lc = vcu & 31, k3 = 3 * (x >> 1), odd = x & 1;
              ATTN_U(k3 + (odd ? 2 : 0), 31 - lc);
              if (lc >= 16) { const int jh = 31 - lc; ATTN_U(k3 + 1, odd ? 30 - 2 * jh : 31 - 2 * jh); }
              const int hf = lc >> 4, d = hf ? lc - 16 : 15 - lc;
              int pre = 0, n = 0;
              for (int dd = 0; dd <= d; ++dd) { pre += n; n = (dd < 2) ? 5 : (dd < 5) ? 4 : (dd < 8) ? 3 : (dd < 11) ? 2 : (dd < 14) ? 1 : 0; }
#pragma unroll 1
              for (int i = 0; i < n; ++i) { const int j = 80 * x + 40 * hf + pre + i; MIX_U((j & 7) * 80 + (j >> 3)); }
          } else {
              for (int r = 0;; ++r) { const int u = r * G + ((r & 1) ? (G - 1 - vcu) : vcu); if (u >= 384) break; ATTN_U(u % 12, 31 - u / 12); }
              for (int j = vcu; j < 640; j += G) MIX_U(j);
          }
#undef ATTN_U
#undef MIX_U
        }
        GSYNC();
#ifndef NO_G2
        for (int rep = 0; rep < ((REP_MASK & 8) ? 2 : 1); ++rep)
        { pg8::Gemm g{Y, (const bf16_t*)(ws + WS_WBT + l * SZ_WBT), M, DM, YW}; pg8::StaticOrder S; S.init(M, DM, G, bx);
          pg8::EpiG2h E{GATES, MERGED};
          pg8::gemm_phase<pg8::EpiG2h, pg8::StaticOrder, true, true>(lds, g, S, E); }
#endif
        GSYNC();
#ifndef NO_G3
        for (int rep = 0; rep < ((REP_MASK & 8) ? 2 : 1); ++rep)
        { pg8::Gemm g{MERGED, (const bf16_t*)(ws + WS_WOT + l * SZ_WOT), M, DM, DM}; pg8::StaticOrder S; S.init(M, DM, G, bx);
          pg8::EpiG3 E{OUTB};
          pg8::gemm_phase<pg8::EpiG3, pg8::StaticOrder, true, true>(lds, g, S, E); }
#endif
        GSYNC();
        rowpass(l == 0 ? p.x : nullptr, XB, (l + 1 < DEPTH) ? nullptr : p.out, OUTB, p.g_post + l * DM, (l + 1 < DEPTH) ? p.g_pre + (l + 1) * DM : nullptr, H, vcu, G);
        if (l + 1 < DEPTH) GSYNC();
    }
}

extern "C" void kernel_launch(void* const* d_in, const int* in_sizes, int n_in, void* d_out, int out_size, void* d_ws, size_t ws_size, hipStream_t stream) {
    static int grid = 0;
    if (grid == 0) {
        if (n_in != 16 || in_sizes[0] != M * DM || out_size != M * DM || ws_size < WS_END) { fprintf(stderr, "kernel_launch: unexpected shapes / workspace (%zu < %zu); nothing launched\n", ws_size, (size_t)WS_END); grid = -1; return; }
        int dev = 0, cus = 0, per_cu = 0;
        hipGetDevice(&dev); hipDeviceGetAttribute(&cus, hipDeviceAttributeMultiprocessorCount, dev);
        if (hipFuncSetAttribute((const void*)mega_fwd, hipFuncAttributeMaxDynamicSharedMemorySize, LDS_BYTES) != hipSuccess) { fprintf(stderr, "kernel_launch: hipFuncSetAttribute failed\n"); grid = -1; return; }
        if (hipOccupancyMaxActiveBlocksPerMultiprocessor(&per_cu, (const void*)mega_fwd, NTHR, LDS_BYTES) != hipSuccess || per_cu < 1) { fprintf(stderr, "kernel_launch: occupancy query failed (%d)\n", per_cu); (void)hipGetLastError(); per_cu = 1; }
        grid = cus * per_cu;
    }
    if (grid < 0) return;
    Params p{};
    p.x = (const float*)d_in[0]; p.rel_bias = (const float*)d_in[1]; p.g_pre = (const float*)d_in[2]; p.w_in = (const float*)d_in[3]; p.w_gate = (const float*)d_in[4];
    p.pool_w = (const float*)d_in[5]; p.pool_scale = (const float*)d_in[6]; p.lam = (const float*)d_in[7]; p.subln_g = (const float*)d_in[8]; p.sgu_ng = (const float*)d_in[9];
    p.sgu_nb = (const float*)d_in[10]; p.sgu_w = (const float*)d_in[11]; p.sgu_b = (const float*)d_in[12]; p.w_branch = (const float*)d_in[13]; p.w_out = (const float*)d_in[14]; p.g_post = (const float*)d_in[15];
    p.out = (float*)d_out; p.ws = (unsigned char*)d_ws;
    void* args[] = {&p};
    hipError_t e = hipLaunchCooperativeKernel((const void*)mega_fwd, dim3(grid), dim3(NTHR), args, LDS_BYTES, stream);
    if (e != hipSuccess) fprintf(stderr, "cooperative launch failed: %s (grid %d)\n", hipGetErrorString(e), grid);
}
```
